# Optimizing an MI355X kernel written in HIP

```python
import jax
import jax.numpy as jnp
from jax import lax
import numpy as np

D_MODEL = 2048
BATCH = 16
SEQ = 256
DEPTH = 4
DEC_BATCH = 8
DEC_SEQ = 2048
PAST_LEN = 512

GRID_W = 64
N_MIXERS = 3
MIXER_OF_LAYER = tuple(i % N_MIXERS for i in range(DEPTH))
LAYER_SLOT = tuple(MIXER_OF_LAYER[:i].count(MIXER_OF_LAYER[i]) for i in range(DEPTH))
N_POOL_LAYERS = MIXER_OF_LAYER.count(0)
N_RWKV_LAYERS = MIXER_OF_LAYER.count(1)
N_ATTN_LAYERS = MIXER_OF_LAYER.count(2)

POOL_WINDOWS = (2, 4, 8, 16)
POOL_GROUP = D_MODEL // len(POOL_WINDOWS)

RWKV_HEAD = 64
RWKV_HEADS = D_MODEL // RWKV_HEAD
DECAY_LORA = 96
AAA_LORA = 96
GATE_LORA = 256
DECAY_SCALE = 0.606531
GN_EPS = 64e-5

ATTN_HEAD_DIM = 128
ATTN_HEADS = 16
ATTN_KV_HEADS = 4
ATTN_GROUP = ATTN_HEADS // ATTN_KV_HEADS
WINDOW = 128
BLOCK = 128
ROPE_BASE = 10000.0
ATTN_SCALE = ATTN_HEAD_DIM ** -0.5
NEG_INF = -1e30

D_FF = 5632
CONV_WIDTH = 3
NORM_EPS = 1e-6

kernel_name = 'hybrid_pool_rwkv7_swa_dit_step'


def rmsnorm(x, g):
    x32 = x.astype(jnp.float32)
    y = x32 * lax.rsqrt(jnp.mean(x32 * x32, axis=-1, keepdims=True) + NORM_EPS)
    return (y * g.astype(jnp.float32)).astype(x.dtype)


def adaln(cond, w, b):
    m = jax.nn.silu(cond) @ w + b
    return jnp.split(m[:, None, :], 6, axis=-1)


def modulate(x, shift, scale):
    return x * (1.0 + scale) + shift


def centred_shift(x):
    xp = jnp.pad(x, ((0, 0), (1, 1), (0, 0)))
    return 0.5 * (xp[:, :-2] + xp[:, 2:]) - x


def pool_mixer(x, w_grp, scale):
    B, T, D = x.shape
    x32 = x.astype(jnp.float32)
    cs = jnp.concatenate([jnp.zeros((B, 1, D), jnp.float32), jnp.cumsum(x32, axis=1)], axis=1)
    t = jnp.arange(T)
    outs = []
    for gi, win in enumerate(POOL_WINDOWS):
        left = win // 2
        right = win - 1 - left
        lo = jnp.clip(t - left, 0, T)
        hi = jnp.clip(t + right + 1, 0, T)
        csg = cs[:, :, gi * POOL_GROUP:(gi + 1) * POOL_GROUP]
        s = jnp.take(csg, hi, axis=1) - jnp.take(csg, lo, axis=1)
        cnt = (hi - lo).astype(jnp.float32)[None, :, None]
        outs.append(s / cnt - x32[:, :, gi * POOL_GROUP:(gi + 1) * POOL_GROUP])
    pooled = jnp.stack(outs, axis=2).astype(x.dtype)
    y = jnp.einsum('btgi,gio->btgo', pooled, w_grp).reshape(B, T, D)
    return y * scale


def rwkv_scan(s0, r, w, k, v, aa, bb, reverse):
    def step(s, inp):
        r_t, w_t, k_t, v_t, a_t, b_t = inp
        sa = jnp.einsum('bhvk,bhk->bhv', s, a_t)
        s = s * w_t[:, :, None, :] + sa[..., None] * b_t[:, :, None, :] + v_t[..., None] * k_t[:, :, None, :]
        return s, jnp.einsum('bhvk,bhk->bhv', s, r_t)
    xs = tuple(jnp.moveaxis(z, 1, 0) for z in (r, w, k, v, aa, bb))
    s_final, o = lax.scan(step, s0.astype(jnp.float32), xs, reverse=reverse)
    return s_final, jnp.moveaxis(o, 0, 1)


def rwkv_mixer(h, p, s0_fwd, s0_bwd):
    B, T, D = h.shape
    H, N = RWKV_HEADS, RWKV_HEAD
    f32 = jnp.float32
    xx = centred_shift(h)
    mu = p['mu']
    xr, xw, xk, xv, xa, xg = (h + xx * mu[i] for i in range(6))
    r = (xr @ p['w_r']).reshape(B, T, H, N).astype(f32)
    k = (xk @ p['w_k']).reshape(B, T, H, N).astype(f32)
    v = (xv @ p['w_v']).reshape(B, T, H, N).astype(f32)
    g = jax.nn.sigmoid(xg @ p['g1']) @ p['g2']
    w_lora = jnp.einsum('ebtr,erd->ebtd', jnp.tanh(jnp.einsum('btd,edr->ebtr', xw, p['w1'])), p['w2'])
    decay = jnp.exp(-DECAY_SCALE * jax.nn.sigmoid((p['w0'][:, None, None, :] + w_lora).astype(f32)))
    decay = decay.reshape(2, B, T, H, N)
    a_lora = jnp.einsum('ebtr,erd->ebtd', jnp.einsum('btd,edr->ebtr', xa, p['a1']), p['a2'])
    a = jax.nn.sigmoid((p['a0'][:, None, None, :] + a_lora).astype(f32)).reshape(2, B, T, H, N)
    kk = k * p['k_k'].reshape(H, N).astype(f32)
    kk = kk / jnp.maximum(jnp.sqrt(jnp.sum(kk * kk, axis=-1, keepdims=True)), 1e-12)
    k_dir = k[None] * (1.0 + (a - 1.0) * p['k_a'].reshape(H, N).astype(f32))
    s_fwd, o_fwd = rwkv_scan(s0_fwd, r, decay[0], k_dir[0], v, -kk, kk * a[0], reverse=False)
    s_bwd, o_bwd = rwkv_scan(s0_bwd, r, decay[1], k_dir[1], v, -kk, kk * a[1], reverse=True)
    o = o_fwd + o_bwd
    mean = jnp.mean(o, axis=-1, keepdims=True)
    var = jnp.mean(jnp.square(o - mean), axis=-1, keepdims=True)
    o = ((o - mean) * lax.rsqrt(var + GN_EPS)).reshape(B, T, D) * p['ln_w'].astype(f32) + p['ln_b'].astype(f32)
    bonus = jnp.sum(r[None] * k_dir * p['r_k'].astype(f32), axis=(0, -1))[..., None] * v
    y = ((o + bonus.reshape(B, T, D)) * g.astype(f32)).astype(h.dtype)
    return y @ p['w_o'], s_fwd, s_bwd


def attn_qkv(h, p):
    B, T, _ = h.shape
    H, KV, Dh = ATTN_HEADS, ATTN_KV_HEADS, ATTN_HEAD_DIM
    qkv = h @ p['w_qkv']
    q = qkv[..., :H * Dh].reshape(B, T, H, Dh)
    k = qkv[..., H * Dh:(H + KV) * Dh].reshape(B, T, KV, Dh)
    v = qkv[..., (H + KV) * Dh:].reshape(B, T, KV, Dh)
    return rmsnorm(q, p['q_norm']), rmsnorm(k, p['k_norm']), v


def axial_rope_tables(T):
    rows = T // GRID_W
    row = jnp.broadcast_to(jnp.arange(rows)[:, None], (rows, GRID_W)).reshape(T).astype(jnp.float32)
    col = jnp.broadcast_to(jnp.arange(GRID_W)[None, :], (rows, GRID_W)).reshape(T).astype(jnp.float32)
    n_freq = ATTN_HEAD_DIM // 4
    inv = ROPE_BASE ** (-jnp.arange(n_freq, dtype=jnp.float32) / n_freq)
    ang = jnp.stack([row[:, None] * inv, col[:, None] * inv], axis=1)
    return jnp.cos(ang), jnp.sin(ang)


def apply_axial_rope(x, cos, sin):
    B, T, Hh, Dh = x.shape
    xs = x.reshape(B, T, Hh, 2, 2, Dh // 4).astype(jnp.float32)
    x1, x2 = xs[..., 0, :], xs[..., 1, :]
    c = cos[None, :, None]
    s = sin[None, :, None]
    out = jnp.stack([x1 * c - x2 * s, x2 * c + x1 * s], axis=-2)
    return out.reshape(B, T, Hh, Dh).astype(x.dtype)


def sink_softmax_attend(q_blk, keys, vals, sink, mask):
    B, Q = q_blk.shape[:2]
    scores = [jnp.einsum('bqkgd,bskd->bkgqs', q_blk, kk).astype(jnp.float32) * ATTN_SCALE for kk in keys]
    if mask is not None:
        scores[0] = jnp.where(mask[None, None, None], scores[0], NEG_INF)
    sink_col = jnp.broadcast_to(sink.reshape(ATTN_KV_HEADS, ATTN_GROUP)[None, :, :, None, None].astype(jnp.float32),
                                (B, ATTN_KV_HEADS, ATTN_GROUP, Q, 1))
    prob = jax.nn.softmax(jnp.concatenate(scores + [sink_col], axis=-1), axis=-1)
    out = None
    off = 0
    for vv in vals:
        n = vv.shape[1]
        o = jnp.einsum('bkgqs,bskd->bqkgd', prob[..., off:off + n].astype(vv.dtype), vv)
        out = o if out is None else out + o
        off += n
    return out


def attn_context(h, p):
    B, T, _ = h.shape
    q, k, v = attn_qkv(h, p)
    nq = T // BLOCK
    qb = jnp.moveaxis(q.reshape(B, nq, BLOCK, ATTN_KV_HEADS, ATTN_GROUP, ATTN_HEAD_DIM), 1, 0)
    o = lax.map(lambda qblk: sink_softmax_attend(qblk, [k], [v], p['sink'], None), qb)
    o = jnp.moveaxis(o, 0, 1).reshape(B, T, ATTN_HEADS * ATTN_HEAD_DIM)
    return o @ p['w_o'], k, v


def attn_latent(h, p, k_ctx, v_ctx):
    B, T, _ = h.shape
    q, k, v = attn_qkv(h, p)
    cos, sin = axial_rope_tables(T)
    q = apply_axial_rope(q, cos, sin)
    k = apply_axial_rope(k, cos, sin)
    nb = T // BLOCK
    qb = jnp.moveaxis(q.reshape(B, nb, BLOCK, ATTN_KV_HEADS, ATTN_GROUP, ATTN_HEAD_DIM), 1, 0)

    def band(z):
        zp = jnp.pad(z, ((0, 0), (BLOCK, BLOCK), (0, 0), (0, 0))).reshape(B, nb + 2, BLOCK, ATTN_KV_HEADS, ATTN_HEAD_DIM)
        zb = jnp.concatenate([zp[:, :-2], zp[:, 1:-1], zp[:, 2:]], axis=2)
        return jnp.moveaxis(zb, 1, 0)

    kb, vb = band(k), band(v)
    blk = jnp.arange(nb)[:, None, None] * BLOCK
    qpos = blk + jnp.arange(BLOCK)[None, :, None]
    kpos = blk + jnp.arange(3 * BLOCK)[None, None, :] - BLOCK
    valid = (jnp.abs(qpos - kpos) <= WINDOW) & (kpos >= 0) & (kpos < T)
    o = lax.map(lambda a: sink_softmax_attend(a[0], [a[1], k_ctx], [a[2], v_ctx], p['sink'], a[3]),
                (qb, kb, vb, valid))
    o = jnp.moveaxis(o, 0, 1).reshape(B, T, ATTN_HEADS * ATTN_HEAD_DIM)
    return o @ p['w_o']


def conv_ffn(h, up, conv_w, conv_b, down):
    T = h.shape[1]
    u = h @ up
    pad = CONV_WIDTH // 2
    up_ = jnp.pad(u, ((0, 0), (pad, pad), (0, 0)))
    u = sum(up_[:, j:j + T] * conv_w[j] for j in range(CONV_WIDTH)) + conv_b
    gate, val = jnp.split(u, 2, axis=-1)
    return (jax.nn.silu(gate) * val) @ down


def setup_inputs(seed: int = 0) -> dict:
    key = jax.random.key(seed)
    ks = iter(jax.random.split(key, 64))

    def nrm(shape, scale):
        return jax.random.normal(next(ks), shape, jnp.float32) * scale

    D, F = D_MODEL, D_FF
    H, N = RWKV_HEADS, RWKV_HEAD
    KV, Dh = ATTN_KV_HEADS, ATTN_HEAD_DIM
    NP, NR, NA = N_POOL_LAYERS, N_RWKV_LAYERS, N_ATTN_LAYERS
    qkv_w = (ATTN_HEADS + 2 * KV) * Dh
    inp = {}
    inp['x_prompt'] = nrm((BATCH, SEQ, D), 1.0)
    inp['x_sample'] = nrm((DEC_BATCH, DEC_SEQ, D), 1.0)
    inp['state_rwkv'] = nrm((DEC_BATCH, NR, 2, H, N, N), 0.5)
    inp['cache_k'] = nrm((DEC_BATCH, NA, PAST_LEN, KV, Dh), 1.0)
    inp['cache_v'] = nrm((DEC_BATCH, NA, PAST_LEN, KV, Dh), 1.0)
    inp['c'] = nrm((DEC_BATCH, D), 1.0)
    inp['c_ctx'] = nrm((D,), 1.0)
    inp['ada_w'] = nrm((DEPTH, D, 6 * D), D ** -0.5)
    inp['ada_b'] = nrm((DEPTH, 6 * D), 0.02)
    inp['norm_mix'] = 1.0 + nrm((DEPTH, D), 0.02)
    inp['norm_ffn'] = 1.0 + nrm((DEPTH, D), 0.02)
    inp['ffn_up'] = nrm((DEPTH, D, 2 * F), D ** -0.5)
    inp['ffn_conv_w'] = nrm((DEPTH, CONV_WIDTH, 2 * F), CONV_WIDTH ** -0.5)
    inp['ffn_conv_b'] = nrm((DEPTH, 2 * F), 0.02)
    inp['ffn_down'] = nrm((DEPTH, F, D), F ** -0.5)
    inp['pool_w'] = nrm((NP, len(POOL_WINDOWS), POOL_GROUP, POOL_GROUP), POOL_GROUP ** -0.5)
    inp['pool_scale'] = 1.0 + nrm((NP, D), 0.1)
    inp['rwkv_mu'] = jax.random.uniform(next(ks), (NR, 6, D), jnp.float32)
    inp['rwkv_w_r'] = nrm((NR, D, D), D ** -0.5)
    inp['rwkv_w_k'] = nrm((NR, D, D), D ** -0.5)
    inp['rwkv_w_v'] = nrm((NR, D, D), D ** -0.5)
    inp['rwkv_w0'] = nrm((NR, 2, D), 0.5)
    inp['rwkv_w1'] = nrm((NR, 2, D, DECAY_LORA), D ** -0.5)
    inp['rwkv_w2'] = nrm((NR, 2, DECAY_LORA, D), 0.5 * DECAY_LORA ** -0.5)
    inp['rwkv_a0'] = nrm((NR, 2, D), 0.5)
    inp['rwkv_a1'] = nrm((NR, 2, D, AAA_LORA), D ** -0.5)
    inp['rwkv_a2'] = nrm((NR, 2, AAA_LORA, D), 0.5 * AAA_LORA ** -0.5)
    inp['rwkv_g1'] = nrm((NR, D, GATE_LORA), D ** -0.5)
    inp['rwkv_g2'] = nrm((NR, GATE_LORA, D), GATE_LORA ** -0.5)
    inp['rwkv_k_k'] = 0.85 + nrm((NR, D), 0.02)
    inp['rwkv_k_a'] = 1.0 + nrm((NR, D), 0.02)
    inp['rwkv_r_k'] = nrm((NR, H, N), 0.1)
    inp['rwkv_ln_w'] = 1.0 + nrm((NR, D), 0.02)
    inp['rwkv_ln_b'] = nrm((NR, D), 0.02)
    inp['rwkv_w_o'] = nrm((NR, D, D), D ** -0.5)
    inp['attn_w_qkv'] = nrm((NA, D, qkv_w), D ** -0.5)
    inp['attn_q_norm'] = 1.0 + nrm((NA, Dh), 0.02)
    inp['attn_k_norm'] = 1.0 + nrm((NA, Dh), 0.02)
    inp['attn_sink'] = nrm((NA, ATTN_HEADS), 0.5)
    inp['attn_w_o'] = nrm((NA, ATTN_HEADS * Dh, D), (ATTN_HEADS * Dh) ** -0.5)
    return inp


def reference(x_prompt, x_sample, state_rwkv, cache_k, cache_v, c, c_ctx,
              ada_w, ada_b, norm_mix, norm_ffn, ffn_up, ffn_conv_w, ffn_conv_b, ffn_down,
              pool_w, pool_scale,
              rwkv_mu, rwkv_w_r, rwkv_w_k, rwkv_w_v, rwkv_w0, rwkv_w1, rwkv_w2,
              rwkv_a0, rwkv_a1, rwkv_a2, rwkv_g1, rwkv_g2, rwkv_k_k, rwkv_k_a, rwkv_r_k,
              rwkv_ln_w, rwkv_ln_b, rwkv_w_o,
              attn_w_qkv, attn_q_norm, attn_k_norm, attn_sink, attn_w_o):
    xp, xs = x_prompt, x_sample
    rwkv_states, ctx_keys, ctx_vals = [], [], []
    for l in range(DEPTH):
        kind, slot = MIXER_OF_LAYER[l], LAYER_SLOT[l]
        sh1p, sc1p, g1p, sh2p, sc2p, g2p = adaln(c_ctx[None, :], ada_w[l], ada_b[l])
        sh1s, sc1s, g1s, sh2s, sc2s, g2s = adaln(c, ada_w[l], ada_b[l])
        hp = modulate(rmsnorm(xp, norm_mix[l]), sh1p, sc1p)
        hs = modulate(rmsnorm(xs, norm_mix[l]), sh1s, sc1s)
        if kind == 0:
            yp = pool_mixer(hp, pool_w[slot], pool_scale[slot])
            ys = pool_mixer(hs, pool_w[slot], pool_scale[slot])
        elif kind == 1:
            p = {'mu': rwkv_mu[slot], 'w_r': rwkv_w_r[slot], 'w_k': rwkv_w_k[slot], 'w_v': rwkv_w_v[slot],
                 'w0': rwkv_w0[slot], 'w1': rwkv_w1[slot], 'w2': rwkv_w2[slot],
                 'a0': rwkv_a0[slot], 'a1': rwkv_a1[slot], 'a2': rwkv_a2[slot],
                 'g1': rwkv_g1[slot], 'g2': rwkv_g2[slot], 'k_k': rwkv_k_k[slot], 'k_a': rwkv_k_a[slot],
                 'r_k': rwkv_r_k[slot], 'ln_w': rwkv_ln_w[slot], 'ln_b': rwkv_ln_b[slot], 'w_o': rwkv_w_o[slot]}
            zero = jnp.zeros((xp.shape[0], RWKV_HEADS, RWKV_HEAD, RWKV_HEAD), jnp.float32)
            yp, s_f, s_b = rwkv_mixer(hp, p, zero, zero)
            rwkv_states.append(jnp.stack([s_f, s_b], axis=1))
            ys, _, _ = rwkv_mixer(hs, p, state_rwkv[:, slot, 0], state_rwkv[:, slot, 1])
        else:
            p = {'w_qkv': attn_w_qkv[slot], 'q_norm': attn_q_norm[slot], 'k_norm': attn_k_norm[slot],
                 'sink': attn_sink[slot], 'w_o': attn_w_o[slot]}
            yp, k_c, v_c = attn_context(hp, p)
            ctx_keys.append(k_c)
            ctx_vals.append(v_c)
            ys = attn_latent(hs, p, cache_k[:, slot], cache_v[:, slot])
        xp = xp + g1p * yp
        xs = xs + g1s * ys
        hp = modulate(rmsnorm(xp, norm_ffn[l]), sh2p, sc2p)
        hs = modulate(rmsnorm(xs, norm_ffn[l]), sh2s, sc2s)
        xp = xp + g2p * conv_ffn(hp, ffn_up[l], ffn_conv_w[l], ffn_conv_b[l], ffn_down[l])
        xs = xs + g2s * conv_ffn(hs, ffn_up[l], ffn_conv_w[l], ffn_conv_b[l], ffn_down[l])
    y_prompt = xp
    y_sample = xs
    new_state_rwkv = jnp.stack(rwkv_states, axis=1)
    new_cache_k = jnp.stack(ctx_keys, axis=1)
    new_cache_v = jnp.stack(ctx_vals, axis=1)
    return (y_prompt, y_sample, new_state_rwkv, new_cache_k, new_cache_v)
```

```cpp
#include <hip/hip_runtime.h>
#include <cstdio>
#include <cstdint>

#ifndef MK_ONE_LAUNCH
#define MK_ONE_LAUNCH 1
#endif

#ifndef MK_MAX_PHASE
#define MK_MAX_PHASE 49
#endif

#ifndef REP_PRO
#define REP_PRO 1
#endif
#ifndef REP_ADA
#define REP_ADA 1
#endif
#ifndef REP_TR
#define REP_TR 1
#endif
#ifndef REP_UP
#define REP_UP 1
#endif
#ifndef REP_CONV
#define REP_CONV 1
#endif
#ifndef REP_SCAN
#define REP_SCAN 1
#endif
#ifndef REP_ATTN
#define REP_ATTN 1
#endif
#ifndef REP_RW
#define REP_RW 1
#endif
#ifndef REP_ELEM
#define REP_ELEM 1
#endif
#ifndef REP_G2
#define REP_G2 1
#endif

#define LAS __attribute__((address_space(3)))
#define GAS __attribute__((address_space(1)))
typedef unsigned short bf16_t;
typedef short bf16x8 __attribute__((ext_vector_type(8)));
typedef short s16x4 __attribute__((ext_vector_type(4)));
typedef float f32x4 __attribute__((ext_vector_type(4)));
typedef float f32x2 __attribute__((ext_vector_type(2)));
typedef float f32x16 __attribute__((ext_vector_type(16)));
typedef unsigned u32x4 __attribute__((ext_vector_type(4)));
typedef unsigned u32x2 __attribute__((ext_vector_type(2)));

constexpr int DM = 2048, FF = 5632, FF2 = 11264;
constexpr int NB_P = 16, T_P = 256, NB_S = 8, T_S = 2048;
constexpr int M_P = NB_P * T_P, M_S = NB_S * T_S, M = M_P + M_S;
constexpr int NCOND = 9, MODW = 6 * DM;
constexpr int NTHREADS = 512, NWAVES = 8;
constexpr float NORM_EPS = 1e-6f;
constexpr int PK = DM + 64;
constexpr int PF = FF + 64;
constexpr int PQ = 3072 + 64;
constexpr int PL1 = 768 + 64;
constexpr int PW2 = 256 + 64;
constexpr int PPW = 512 + 64;

enum { I_XP = 0, I_XS, I_STATE, I_CK, I_CV, I_C, I_CCTX, I_ADAW, I_ADAB, I_NMIX, I_NFFN, I_UP, I_CONVW, I_CONVB, I_DOWN, I_POOLW, I_POOLS,
       I_MU, I_WR, I_WK, I_WV, I_W0, I_W1, I_W2, I_A0, I_A1, I_A2, I_G1, I_G2, I_KK, I_KA, I_RK, I_LNW, I_LNB, I_WO,
       I_QKV, I_QN, I_KN, I_SINK, I_AO, N_IN };

constexpr size_t OUT_X = 0;
constexpr size_t OUT_STATE = (size_t)M * DM;
constexpr size_t OUT_CK = OUT_STATE + (size_t)16 * 2 * 32 * 4096;
constexpr size_t OUT_CV = OUT_CK + (size_t)16 * 256 * 512;
constexpr size_t OUT_TOTAL = OUT_CV + (size_t)16 * 256 * 512;

constexpr size_t MiB = 1u << 20;
constexpr size_t WS_CTL = 0, CTL_BYTES = 64 * 1024;
constexpr int CW_BAR = 1024;
constexpr size_t WS_MOD = 2 * MiB;
constexpr int RSQ_PARTS = 32;
constexpr size_t WS_RSQ = 4 * MiB, SZ_RSQ = (size_t)RSQ_PARTS * M * 4;
constexpr size_t WS_W = 28 * MiB;
constexpr size_t SZ_UP = (size_t)FF2 * PK * 2, SZ_DN = (size_t)DM * PF * 2, SZ_SQ = (size_t)DM * PK * 2;
constexpr size_t WS_WUP = WS_W;
constexpr size_t WS_WDN = WS_WUP + 4 * SZ_UP;
constexpr size_t WS_WPOOL = WS_WDN + 4 * SZ_DN;
constexpr size_t WS_WR = WS_WPOOL + 2 * (size_t)DM * PPW * 2;
constexpr size_t WS_WL1 = WS_WR + 4 * SZ_SQ;
constexpr size_t WS_WW2 = WS_WL1 + (size_t)768 * PK * 2;
constexpr size_t WS_WA2 = WS_WW2 + (size_t)4096 * PW2 * 2;
constexpr size_t WS_WG2 = WS_WA2 + (size_t)4096 * PW2 * 2;
constexpr size_t WS_WQKV = WS_WG2 + (size_t)2048 * PW2 * 2;
constexpr size_t WS_WAO = WS_WQKV + (size_t)3072 * PK * 2;
constexpr size_t WS_CKB = WS_WAO + SZ_SQ;
constexpr size_t WS_CVB = WS_CKB + (size_t)8 * 512 * 512 * 2;
constexpr size_t WS_ACT = ((WS_CVB + (size_t)8 * 512 * 512 * 2 + MiB - 1) / MiB) * MiB;
constexpr size_t SZ_H = (size_t)M * PK * 2;
constexpr size_t WS_H = WS_ACT;
constexpr size_t WS_U = WS_H + SZ_H;
constexpr size_t WS_ACTB = WS_U + 16 * MiB;
constexpr size_t WS_FFN_END = WS_ACTB + (size_t)M * PF * 2;
constexpr size_t WS_X6 = WS_ACT;
constexpr size_t WS_DEC = WS_X6, WS_AA = WS_DEC + (size_t)2 * M * PK * 4;
constexpr size_t WS_RKV = WS_X6 + 6 * SZ_H;
constexpr size_t WS_L1 = WS_RKV + 3 * SZ_H;
constexpr size_t WS_G = WS_L1 + (size_t)M * PL1 * 2;
constexpr size_t WS_OFB = WS_G + SZ_H;
constexpr size_t WS_Y = WS_RKV + 2 * SZ_H;
constexpr size_t WS_XB = WS_OFB + 2 * SZ_H;
constexpr size_t WS_RWKV_END = WS_XB + SZ_H;
constexpr size_t WS_QKVB = WS_ACT + SZ_H;
constexpr size_t WS_AOB = WS_QKVB + (size_t)M * PQ * 2;
constexpr size_t WS_END = WS_RWKV_END > WS_FFN_END ? WS_RWKV_END : WS_FFN_END;
static_assert(WS_AA + (size_t)2 * M * PK * 2 == WS_RKV, "DEC + AA overlay the six shifted inputs exactly");
static_assert((size_t)80 * 4 * FF2 * 4 <= 16 * MiB && WS_END <= 1536 * MiB, "halo rows fit their slot; the whole map fits the guaranteed workspace (4 x the largest input tensor)");

constexpr int LDS_BYTES = 147456;
constexpr int LDS_MISC = 131072 + 8192;

typedef __bf16 bf16x2_hw __attribute__((ext_vector_type(2)));
__device__ __forceinline__ unsigned pk2(float lo, float hi) { const f32x2 v = {lo, hi}; const bf16x2_hw b = __builtin_convertvector(v, bf16x2_hw); return __builtin_bit_cast(unsigned, b); }
__device__ __forceinline__ unsigned f2bf(float f) { return pk2(f, f) & 0xffffu; }
__device__ __forceinline__ float bf2f(unsigned short b) { return __builtin_bit_cast(float, ((unsigned)b) << 16); }
__device__ __forceinline__ float bflo(unsigned w) { return __builtin_bit_cast(float, w << 16); }
__device__ __forceinline__ float bfhi(unsigned w) { return __builtin_bit_cast(float, w & 0xffff0000u); }
__device__ __forceinline__ f32x4 bf4_to_f32(u32x2 w) { return (f32x4){bflo(w.x), bfhi(w.x), bflo(w.y), bfhi(w.y)}; }
__device__ __forceinline__ u32x2 f32_to_bf4(f32x4 v) { u32x2 w; w.x = pk2(v.x, v.y); w.y = pk2(v.z, v.w); return w; }
__device__ __forceinline__ float wave_sum(float v) {
#pragma unroll
    for (int o = 1; o < 64; o <<= 1) v += __shfl_xor(v, o);
    return v;
}
#define DPP_ADD(x, ctrl) ((x) + __builtin_bit_cast(float, __builtin_amdgcn_update_dpp(0, __builtin_bit_cast(int, (x)), (ctrl), 0xF, 0xF, true)))
__device__ __forceinline__ float row16_sum(float v) {
    v = DPP_ADD(v, 0xB1); v = DPP_ADD(v, 0x4E); v = DPP_ADD(v, 0x141); v = DPP_ADD(v, 0x140);
    return v;
}
__device__ __forceinline__ float sigmoidf_(float x) { return __builtin_amdgcn_rcpf(1.f + __expf(-x)); }
__device__ __forceinline__ float siluf_(float x) { return x * __builtin_amdgcn_rcpf(1.f + __expf(-x)); }
__device__ __forceinline__ float tanhf_(float x) { return 1.f - 2.f * __builtin_amdgcn_rcpf(1.f + __expf(2.f * x)); }
__device__ __forceinline__ int cond_of_row(int m) { return m < M_P ? 0 : 1 + ((m - M_P) >> 11); }
struct RowSq { const float* p; int n; };
__device__ __forceinline__ float rowsq_wave(RowSq r, int m, int lane) { const float v = lane < r.n ? r.p[(size_t)lane * M + m] : 0.f; return wave_sum(v); }
__device__ __forceinline__ float rowsq_seq(RowSq r, int m) { float s = 0.f; for (int i = 0; i < r.n; ++i) s += r.p[(size_t)i * M + m]; return s; }

__device__ __forceinline__ int opaque_tid() { int t = threadIdx.x; asm volatile("" : "+v"(t)); return t; }

#define XB_TMO      128
#define XB_XCNT(j)  (256  + 64 * (j))
#define XB_XSUB(j)  (1280 + 64 * (j))
#define XB_XGEN(j)  (2304 + 64 * (j))
#define XB_TOP      3328
#define XB_TOPGEN   3392
#define XCD_BAR_WORDS 3456
#define XB_SPIN_CAP (1u << 20)

__device__ __forceinline__ unsigned xb_ld(unsigned* p)              { return __hip_atomic_load(p, __ATOMIC_RELAXED, __HIP_MEMORY_SCOPE_AGENT); }
__device__ __forceinline__ unsigned xb_add(unsigned* p, unsigned v) { return __hip_atomic_fetch_add(p, v, __ATOMIC_RELAXED, __HIP_MEMORY_SCOPE_AGENT); }
__device__ __forceinline__ unsigned xb_xcc_id() { return (unsigned)__builtin_amdgcn_s_getreg((3 << 11) | 20) & 0xFu; }
#define XB_SPIN(cond, bar) do { unsigned _sp = 0; while (cond) { __builtin_amdgcn_s_sleep(1); \
    if ((++_sp & 255u) == 0u) { if (xb_ld(&(bar)[XB_TMO])) break; if (_sp > XB_SPIN_CAP) { atomicAdd(&(bar)[XB_TMO], 1u); break; } } } } while (0)

struct XcdBarrier { unsigned* bar; unsigned x; volatile LAS unsigned* st; };

__device__ __forceinline__ XcdBarrier xcd_barrier_post(unsigned* bar, volatile LAS unsigned* st) {
    XcdBarrier b; b.bar = bar; b.x = xb_xcc_id(); b.st = st;
    if (threadIdx.x == 0) (void)xb_add(&bar[XB_XCNT(b.x)], 1u);
    return b;
}
__device__ __forceinline__ void xcd_barrier_complete(unsigned* bar, unsigned x, unsigned& nloc, unsigned& nx) {
    const unsigned G = gridDim.x * gridDim.y * gridDim.z;
    unsigned sum, cnt, mine, sp = 0u;
    for (;;) {
        sum = 0u; cnt = 0u; mine = 0u;
#pragma unroll
        for (unsigned j = 0; j < 16; ++j) { const unsigned c = xb_ld(&bar[XB_XCNT(j)]); sum += c; cnt += (c > 0u) ? 1u : 0u; mine = (j == x) ? c : mine; }
        if (sum == G) break;
        __builtin_amdgcn_s_sleep(1);
        if ((++sp & 255u) == 0u) { if (xb_ld(&bar[XB_TMO])) break; if (sp > XB_SPIN_CAP) { atomicAdd(&bar[XB_TMO], 1u); break; } }
    }
    nloc = mine > 0u ? mine : 1u; nx = cnt > 0u ? cnt : 1u;
}
__device__ __forceinline__ void xcd_barrier(const XcdBarrier& b) {
    asm volatile("s_waitcnt vmcnt(0)" ::: "memory");
    __syncthreads();
    if (threadIdx.x == 0) {
        unsigned* bar = b.bar;
        __builtin_amdgcn_s_waitcnt(0);
        unsigned nloc = b.st[0], nx = b.st[1];
        if (nloc == 0u) { xcd_barrier_complete(bar, b.x, nloc, nx); b.st[0] = nloc; b.st[1] = nx; }
        const unsigned old = xb_add(&bar[XB_XSUB(b.x)], 1u);
        const unsigned gen = old / nloc;
        if (old + 1u == (gen + 1u) * nloc) {
            __builtin_amdgcn_fence(__ATOMIC_RELEASE, "agent");
            asm volatile("s_waitcnt vmcnt(0)" ::: "memory");
            const unsigned og = xb_add(&bar[XB_TOP], 1u);
            const unsigned tg = og / nx;
            if (og + 1u == (tg + 1u) * nx) xb_add(&bar[XB_TOPGEN], 1u);
            else XB_SPIN(xb_ld(&bar[XB_TOPGEN]) == tg, bar);
            __builtin_amdgcn_fence(__ATOMIC_ACQUIRE, "agent");
            xb_add(&bar[XB_XGEN(b.x)], 1u);
            asm volatile("s_waitcnt vmcnt(0)" ::: "memory");
        } else {
            XB_SPIN(xb_ld(&bar[XB_XGEN(b.x)]) == gen, bar);
            __builtin_amdgcn_fence(__ATOMIC_ACQUIRE, "agent");
            asm volatile("s_waitcnt vmcnt(0)" ::: "memory");
        }
    }
    __syncthreads();
}

namespace pg8 {
constexpr bool KALT = true;
constexpr int BM = 256, BK = 64, HALF = 128, HTB = HALF * BK * 2  , STAGE_BYTES = 8 * HTB, NXCD = 8, WGM = 8;

__host__ __device__ __forceinline__ int lds_byte(int r, int c) { const int st = (r >> 4) * 2 + (c >> 5), rr = r & 15, cc = c & 31, ob = rr * 64 + cc * 2; return st * 1024 + (ob ^ (((ob >> 9) & 1) << 5)); }
__host__ __device__ __forceinline__ void stage_rc(int b, int& R, int& C) { const int st = b / 1024, sb = b % 1024, swz = sb ^ (((sb >> 9) & 1) << 5); R = (st >> 1) * 16 + swz / 64; C = (st & 1) * 32 + (swz % 64) / 2; }

struct Unit { int pm, pn, sub, pnl, nt; const char* a; const char* b; };

struct TileOrder {
    int nM, nN, nwg, G, c;
    __device__ void init(int nM_, int nN_, int G_, int c_) { nM = nM_; nN = nN_; nwg = nM * nN; G = G_; c = c_; }
    __device__ bool next(int i, int& pm, int& pn) const {
        const long L = (long)i * G + c; if (L >= nwg) return false;
        int wgid = (int)L; { const int q = nwg / NXCD, r = nwg % NXCD, xcd = wgid % NXCD, off = wgid / NXCD; wgid = (xcd < r ? xcd * (q + 1) : r * (q + 1) + (xcd - r) * q) + off; }
        const int nig = WGM * nN, gid = wgid / nig, fm = gid * WGM, gsz = (nM - fm) < WGM ? (nM - fm) : WGM;
        pm = fm + ((wgid % nig) % gsz); pn = (wgid % nig) / gsz; return true;
    }
};

template <class Epi, class Prob, bool ALIGN_EPI, bool SP2>
__device__ __forceinline__ void gemm_phase(LAS unsigned char* lds, const Prob& P, const Epi& E) {
    const int tid = opaque_tid(), wid = __builtin_amdgcn_readfirstlane(tid >> 6), lane = tid & 63, wr = wid >> 2, wc = wid & 3, fr = lane & 15, fq = lane >> 4;
    const int K = P.K, nt = K / BK;
    TileOrder S; S.init(P.nM, P.nN, (int)gridDim.x, (int)blockIdx.x);
    unsigned voffA[2], voffB[2];
#pragma unroll
    for (int i = 0; i < 2; ++i) { int R, C; stage_rc(tid * 16 + i * 8192, R, C);
        voffA[i] = (unsigned)(R * P.lda + C) * 2u; voffB[i] = (unsigned)(R * P.ldb + C) * 2u; }
    const int kfwd = BK * 2;
    const size_t hstepA = (size_t)HALF * P.lda * 2, hstepB = (size_t)HALF * P.ldb * 2;
    const unsigned ldsw = (unsigned)wid * 1024u;
    const int aoff = lds_byte(wr * 64 + fr, fq * 8), boff = lds_byte(wc * 32 + fr, fq * 8);
#define PG8_SA(b, h) (((b) * 2 + (h)) * HTB)
#define PG8_SB(b, h) ((4 + (b) * 2 + (h)) * HTB)
#define PG8_STAGE(bufoff, gbase, voff) do { _Pragma("unroll") for (int _i = 0; _i < 2; ++_i) \
        __builtin_amdgcn_global_load_lds((const unsigned*)((const char*)(gbase) + (voff)[_i]), (LAS unsigned*)(lds + (bufoff) + ldsw + _i * 8192), 16, 0, 0); } while (0)
#define PG8_LDA(dst, b, h) do { _Pragma("unroll") for (int m = 0; m < 4; ++m) _Pragma("unroll") for (int k = 0; k < 2; ++k) dst[m][k] = *(const LAS bf16x8*)(lds + PG8_SA(b, h) + aoff + m * 2048 + k * 1024); } while (0)
#define PG8_LDB(dst, b, h) do { _Pragma("unroll") for (int n = 0; n < 2; ++n) _Pragma("unroll") for (int k = 0; k < 2; ++k) dst[n][k] = *(const LAS bf16x8*)(lds + PG8_SB(b, h) + boff + n * 2048 + k * 1024); } while (0)
#define PG8_MMA(ai, bj, At, Bt) do { __builtin_amdgcn_s_setprio(1); _Pragma("unroll") for (int m = 0; m < 4; ++m) _Pragma("unroll") for (int n = 0; n < 2; ++n) _Pragma("unroll") for (int k = 0; k < 2; ++k) \
        acc[ai][bj][m][n] = __builtin_amdgcn_mfma_f32_16x16x32_bf16(Bt[n][k], At[m][k], acc[ai][bj][m][n], 0, 0, 0); __builtin_amdgcn_s_setprio(0); } while (0)
#define PG8_WAIT_V(n) asm volatile("s_waitcnt vmcnt(" #n ")" ::: "memory")
#define PG8_WAIT_L(n) asm volatile("s_waitcnt lgkmcnt(" #n ")" ::: "memory")
#define PG8_BAR __builtin_amdgcn_s_barrier()
#define PG8_SCHED __builtin_amdgcn_sched_barrier(0)
    Unit cur, nxt; int ui = 0;
    if (!S.next(0, cur.pm, cur.pn)) return;
    P.locate(cur);
    int ntc = nt;
    if constexpr (Prob::VAR_NT) ntc = cur.nt;
    f32x4 acc[2][2][4][2];
#pragma unroll
    for (int a = 0; a < 2; ++a)
#pragma unroll
        for (int b = 0; b < 2; ++b)
#pragma unroll
            for (int m = 0; m < 4; ++m)
#pragma unroll
                for (int n = 0; n < 2; ++n) acc[a][b][m][n] = (f32x4){0.f, 0.f, 0.f, 0.f};
    bf16x8 At[4][2], B0[2][2], B1[2][2];
    const char* cA = cur.a; const char* cB = cur.b; int kstep = kfwd;
    if constexpr (SP2) {
        PG8_STAGE(PG8_SB(0, 0), cB, voffB); PG8_STAGE(PG8_SB(0, 1), cB + hstepB, voffB); PG8_STAGE(PG8_SA(0, 0), cA, voffA); PG8_STAGE(PG8_SA(0, 1), cA + hstepA, voffA);
        if (wr == 1) PG8_BAR;
        PG8_WAIT_V(2); PG8_BAR;
        PG8_STAGE(PG8_SB(1, 0), cB + kstep, voffB); PG8_STAGE(PG8_SA(1, 0), cA + kstep, voffA); PG8_STAGE(PG8_SB(1, 1), cB + hstepB + kstep, voffB);
        PG8_WAIT_V(6); PG8_BAR;
    } else {
        PG8_STAGE(PG8_SB(0, 0), cB, voffB); PG8_STAGE(PG8_SA(0, 0), cA, voffA); PG8_STAGE(PG8_SB(0, 1), cB + hstepB, voffB); PG8_STAGE(PG8_SA(0, 1), cA + hstepA, voffA);
        if (wr == 1) PG8_BAR;
        PG8_WAIT_V(4); PG8_BAR;
        PG8_STAGE(PG8_SB(1, 0), cB + kstep, voffB); PG8_STAGE(PG8_SA(1, 0), cA + kstep, voffA); PG8_STAGE(PG8_SB(1, 1), cB + hstepB + kstep, voffB);
        PG8_WAIT_V(6); PG8_BAR;
    }
    for (;;) {
        const bool has_next = S.next(ui + 1, nxt.pm, nxt.pn);
        if (has_next) P.locate(nxt);
        int ntn = ntc; if constexpr (Prob::VAR_NT) { if (has_next) ntn = nxt.nt; }
        const int nstep = KALT ? -kstep : kstep, noff = (KALT && nstep < 0) ? (ntn - 1) * kfwd : 0;
        const char* nA = has_next ? nxt.a + noff : cA; const char* nB = has_next ? nxt.b + noff : cB;
        const int nst = has_next ? nstep : kstep;
        for (int t = 0; t < ntc; t += 2) {
            const bool last = (t == ntc - 2);
            const char* a1 = cA + (t + 1) * kstep;
            const char* a2 = last ? nA : cA + (t + 2) * kstep; const char* b2 = last ? nB : cB + (t + 2) * kstep;
            const char* a3 = a2 + (last ? nst : kstep); const char* b3 = b2 + (last ? nst : kstep);
            if constexpr (SP2) {
            PG8_LDB(B0, 0, 0); PG8_LDB(B1, 0, 1); PG8_SCHED; PG8_LDA(At, 0, 0); PG8_STAGE(PG8_SA(1, 1), a1 + hstepA, voffA);
            PG8_WAIT_V(8); PG8_WAIT_L(0); PG8_BAR; PG8_MMA(0, 0, At, B0); PG8_MMA(0, 1, At, B1); PG8_BAR; PG8_SCHED;
            PG8_LDA(At, 0, 1); PG8_STAGE(PG8_SB(0, 0), b2, voffB); PG8_STAGE(PG8_SB(0, 1), b2 + hstepB, voffB); PG8_STAGE(PG8_SA(0, 0), a2, voffA);
            PG8_WAIT_V(8); PG8_WAIT_L(0); PG8_BAR; PG8_MMA(1, 0, At, B0); PG8_MMA(1, 1, At, B1); PG8_BAR; PG8_SCHED;
            PG8_LDB(B0, 1, 0); PG8_LDB(B1, 1, 1); PG8_SCHED; PG8_LDA(At, 1, 0); PG8_STAGE(PG8_SA(0, 1), a2 + hstepA, voffA);
            PG8_WAIT_V(8); PG8_WAIT_L(0); PG8_BAR; PG8_MMA(0, 0, At, B0); PG8_MMA(0, 1, At, B1); PG8_BAR; PG8_SCHED;
            PG8_LDA(At, 1, 1); PG8_STAGE(PG8_SB(1, 0), b3, voffB); PG8_STAGE(PG8_SB(1, 1), b3 + hstepB, voffB); PG8_STAGE(PG8_SA(1, 0), a3, voffA);
            PG8_WAIT_V(8); PG8_WAIT_L(0); PG8_BAR; PG8_MMA(1, 0, At, B0); PG8_MMA(1, 1, At, B1); PG8_BAR; PG8_SCHED;
            } else {
            PG8_LDB(B0, 0, 0); PG8_SCHED; PG8_LDA(At, 0, 0); PG8_STAGE(PG8_SA(1, 1), a1 + hstepA, voffA);
            PG8_WAIT_L(8); PG8_BAR; PG8_WAIT_L(0); PG8_MMA(0, 0, At, B0); PG8_BAR; PG8_SCHED;
            PG8_LDB(B1, 0, 1); PG8_STAGE(PG8_SB(0, 0), b2, voffB);
            PG8_BAR; PG8_WAIT_L(0); PG8_MMA(0, 1, At, B1); PG8_BAR;
            PG8_LDA(At, 0, 1); PG8_STAGE(PG8_SA(0, 0), a2, voffA);
            PG8_BAR; PG8_WAIT_L(0); PG8_MMA(1, 0, At, B0); PG8_BAR; PG8_SCHED;
            PG8_STAGE(PG8_SB(0, 1), b2 + hstepB, voffB);
            PG8_WAIT_V(6); PG8_BAR; PG8_MMA(1, 1, At, B1); PG8_BAR;
            PG8_LDB(B0, 1, 0); PG8_SCHED; PG8_LDA(At, 1, 0); PG8_STAGE(PG8_SA(0, 1), a2 + hstepA, voffA);
            PG8_WAIT_L(8); PG8_BAR; PG8_WAIT_L(0); PG8_MMA(0, 0, At, B0); PG8_BAR; PG8_SCHED;
            PG8_LDB(B1, 1, 1); PG8_STAGE(PG8_SB(1, 0), b3, voffB);
            PG8_BAR; PG8_WAIT_L(0); PG8_MMA(0, 1, At, B1); PG8_BAR;
            PG8_LDA(At, 1, 1); PG8_STAGE(PG8_SA(1, 0), a3, voffA);
            PG8_BAR; PG8_WAIT_L(0); PG8_MMA(1, 0, At, B0); PG8_BAR; PG8_SCHED;
            PG8_STAGE(PG8_SB(1, 1), b3 + hstepB, voffB);
            PG8_WAIT_V(6); PG8_BAR; PG8_MMA(1, 1, At, B1); PG8_BAR;
            }
        }
        if constexpr (ALIGN_EPI) { if (wr == 0) PG8_BAR; }
        E(acc, cur, wr, wc, fr, fq);
        if (!has_next) break;
#pragma unroll
        for (int a = 0; a < 2; ++a)
#pragma unroll
            for (int b = 0; b < 2; ++b)
#pragma unroll
                for (int m = 0; m < 4; ++m)
#pragma unroll
                    for (int n = 0; n < 2; ++n) acc[a][b][m][n] = (f32x4){0.f, 0.f, 0.f, 0.f};
        cur = nxt; cA = nA; cB = nB; kstep = nst; ntc = ntn; ++ui;
        if constexpr (ALIGN_EPI) { if (wr == 1) PG8_BAR; }
    }
    PG8_WAIT_V(0);
    if constexpr (!ALIGN_EPI) { if (wr == 0) PG8_BAR; }
    PG8_BAR;
#undef PG8_SA
#undef PG8_SB
#undef PG8_STAGE
#undef PG8_LDA
#undef PG8_LDB
#undef PG8_MMA
#undef PG8_WAIT_V
#undef PG8_WAIT_L
#undef PG8_BAR
#undef PG8_SCHED
}
}

struct ProbSimple {
    static constexpr bool VAR_NT = false;
    const bf16_t* A; const bf16_t* Bt; int lda, ldb, K, nM, nN;
    __device__ __forceinline__ void locate(pg8::Unit& u) const { u.sub = 0; u.pnl = u.pn;
        u.a = (const char*)A + (size_t)u.pm * 256 * lda * 2; u.b = (const char*)Bt + (size_t)u.pn * 256 * ldb * 2; }
};
struct ProbPool {
    static constexpr bool VAR_NT = false;
    const bf16_t* A; const bf16_t* Bt; int lda, ldb, K, nM, nN;
    __device__ __forceinline__ void locate(pg8::Unit& u) const { u.sub = 0; u.pnl = u.pn;
        u.a = (const char*)A + ((size_t)u.pm * 256 * lda + (size_t)(u.pn >> 1) * 512) * 2; u.b = (const char*)Bt + (size_t)u.pn * 256 * ldb * 2; }
};
struct ProbRwkv1 {
    static constexpr bool VAR_NT = false;
    const bf16_t* X6; const bf16_t* Wrkv; const bf16_t* Wl1; int lda, ldb, K, nM, nN;
    __device__ __forceinline__ void locate(pg8::Unit& u) const {
        int xi; const char* b;
        if (u.pn < 24) { u.sub = u.pn >> 3; u.pnl = u.pn & 7; xi = u.sub == 0 ? 0 : (u.sub == 1 ? 2 : 3); b = (const char*)Wrkv + (size_t)u.sub * SZ_SQ + (size_t)u.pnl * 256 * ldb * 2; }
        else { const int j = u.pn - 24; u.sub = 3 + j; u.pnl = 0; xi = j == 0 ? 1 : (j == 1 ? 4 : 5); b = (const char*)Wl1 + (size_t)j * 256 * ldb * 2; }
        u.a = (const char*)X6 + (size_t)xi * SZ_H + (size_t)u.pm * 256 * lda * 2; u.b = b; }
};
struct ProbRwkv2 {
    static constexpr bool VAR_NT = true;
    const bf16_t* L1; const bf16_t* Ww2; const bf16_t* Wa2; const bf16_t* Wg2; int lda, ldb, K, nM, nN;
    __device__ __forceinline__ void locate(pg8::Unit& u) const {
        const bf16_t* w;
        if (u.pn < 16) { u.sub = 0; u.pnl = u.pn; w = Ww2; } else if (u.pn < 32) { u.sub = 1; u.pnl = u.pn - 16; w = Wa2; } else { u.sub = 2; u.pnl = u.pn - 32; w = Wg2; }
        const int e = u.sub < 2 ? (u.pnl >> 3) : 0; u.nt = u.sub < 2 ? 2 : 4;
        u.a = (const char*)L1 + ((size_t)u.pm * 256 * lda + (size_t)u.sub * 256 + (size_t)e * 128) * 2; u.b = (const char*)w + (size_t)u.pnl * 256 * ldb * 2; }
};

#define EPI_ARGS const f32x4 (&acc)[2][2][4][2], const pg8::Unit& u, int wr, int wc, int fr, int fq
struct EpiResid {
    float* xf; bf16_t* xb; const float* gate; const float* cscale; float* rowsq; const float* xs_lo; const float* xs_hi; int mode;
    template <int MODE> __device__ __forceinline__ void run(EPI_ARGS) const {
        const int cond = u.pm < 16 ? 0 : 1 + ((u.pm - 16) >> 3);
        const int col0 = u.pn * 256 + wc * 32 + 4 * fq;
        const float* gp = gate + (size_t)cond * MODW + col0;
        f32x4 gv[2][2];
#pragma unroll
        for (int bj = 0; bj < 2; ++bj)
#pragma unroll
            for (int n = 0; n < 2; ++n) { gv[bj][n] = *(const f32x4*)(gp + bj * 128 + n * 16); if (cscale) gv[bj][n] *= *(const f32x4*)(cscale + col0 + bj * 128 + n * 16); }
#pragma unroll
        for (int ai = 0; ai < 2; ++ai)
#pragma unroll
            for (int m = 0; m < 4; ++m) {
                const int row = u.pm * 256 + ai * 128 + wr * 64 + m * 16 + fr; float ss = 0.f;
                bf16_t* xbr = xb + (size_t)row * PK + col0;
#pragma unroll
                for (int bj = 0; bj < 2; ++bj)
#pragma unroll
                    for (int n = 0; n < 2; ++n) { f32x4 xv;
                        if constexpr (MODE == 0) xv = *(const f32x4*)((u.pm < 16 ? xs_lo + (size_t)row * DM : xs_hi + (size_t)(row - M_P) * DM) + col0 + bj * 128 + n * 16);
                        else xv = bf4_to_f32(*(const u32x2*)(xbr + bj * 128 + n * 16));
                        xv += gv[bj][n] * acc[ai][bj][m][n];
                        if constexpr (MODE == 2) *(f32x4*)(xf + (size_t)row * DM + col0 + bj * 128 + n * 16) = xv;
                        else { const u32x2 w = f32_to_bf4(xv); *(u32x2*)(xbr + bj * 128 + n * 16) = w; xv = bf4_to_f32(w); }
                        ss += (xv.x * xv.x + xv.y * xv.y) + (xv.z * xv.z + xv.w * xv.w); }
                ss += __shfl_xor(ss, 16); ss += __shfl_xor(ss, 32);
                if (fq == 0) rowsq[(size_t)(u.pn * 4 + wc) * M + row] = ss;
            }
    }
    __device__ __forceinline__ void operator()(EPI_ARGS) const {
        if (mode == 0) run<0>(acc, u, wr, wc, fr, fq); else if (mode == 1) run<1>(acc, u, wr, wc, fr, fq); else run<2>(acc, u, wr, wc, fr, fq);
    }
};
struct EpiBf16 {
    bf16_t* out; int ldc;
    __device__ __forceinline__ void operator()(EPI_ARGS) const {
        const int col0 = u.pn * 256 + wc * 32 + 4 * fq;
#pragma unroll
        for (int ai = 0; ai < 2; ++ai)
#pragma unroll
            for (int m = 0; m < 4; ++m) {
                const int row = u.pm * 256 + ai * 128 + wr * 64 + m * 16 + fr; bf16_t* op = out + (size_t)row * ldc + col0;
#pragma unroll
                for (int bj = 0; bj < 2; ++bj)
#pragma unroll
                    for (int n = 0; n < 2; ++n) *(u32x2*)(op + bj * 128 + n * 16) = f32_to_bf4(acc[ai][bj][m][n]);
            }
    }
};

__device__ __forceinline__ float dpp_ror1(float x)  { return __builtin_bit_cast(float, __builtin_amdgcn_update_dpp(0, __builtin_bit_cast(int, x), 0x121, 0xF, 0xF, true)); }
__device__ __forceinline__ float dpp_ror15(float x) { return __builtin_bit_cast(float, __builtin_amdgcn_update_dpp(0, __builtin_bit_cast(int, x), 0x12F, 0xF, 0xF, true)); }
__device__ __forceinline__ float dpp_shr1_old(float old, float x) { return __builtin_bit_cast(float, __builtin_amdgcn_update_dpp(__builtin_bit_cast(int, old), __builtin_bit_cast(int, x), 0x111, 0xF, 0xF, false)); }
__device__ __forceinline__ float dpp_shl1_old(float old, float x) { return __builtin_bit_cast(float, __builtin_amdgcn_update_dpp(__builtin_bit_cast(int, old), __builtin_bit_cast(int, x), 0x101, 0xF, 0xF, false)); }
struct EpiUpConv {
    bf16_t* act; float* halo; const float* cw; const float* cb; LAS float* xch;
    __device__ __forceinline__ void operator()(EPI_ARGS) const {
        const int cl = 32 * wc + 4 * fq;
#pragma unroll
        for (int ai = 0; ai < 2; ++ai) { const int seg = 2 * ai + wr;
            if (fr == 0) {
#pragma unroll
                for (int bj = 0; bj < 2; ++bj)
#pragma unroll
                    for (int n = 0; n < 2; ++n) *(LAS f32x4*)(xch + ((((seg * 4 + wc) * 2 + 0) * 2 + bj) * 2 + n) * 16 + 4 * fq) = acc[ai][bj][0][n]; }
            if (fr == 15) {
#pragma unroll
                for (int bj = 0; bj < 2; ++bj)
#pragma unroll
                    for (int n = 0; n < 2; ++n) *(LAS f32x4*)(xch + ((((seg * 4 + wc) * 2 + 1) * 2 + bj) * 2 + n) * 16 + 4 * fq) = acc[ai][bj][3][n]; } }
        if (wr == 0 && fr < 2) {
#pragma unroll
            for (int bj = 0; bj < 2; ++bj)
#pragma unroll
                for (int n = 0; n < 2; ++n) *(f32x4*)(halo + ((size_t)u.pm * 4 + fr) * FF2 + u.pn * 256 + bj * 128 + cl + 16 * n) = acc[0][bj][0][n]; }
        if (wr == 1 && fr >= 14) {
#pragma unroll
            for (int bj = 0; bj < 2; ++bj)
#pragma unroll
                for (int n = 0; n < 2; ++n) *(f32x4*)(halo + ((size_t)u.pm * 4 + 2 + (fr - 14)) * FF2 + u.pn * 256 + bj * 128 + cl + 16 * n) = acc[1][bj][3][n]; }
        asm volatile("s_waitcnt lgkmcnt(0)" ::: "memory"); __builtin_amdgcn_s_barrier(); asm volatile("" ::: "memory");
#pragma unroll
        for (int n = 0; n < 2; ++n) {
            const int ch = u.pn * 128 + cl + 16 * n;
            f32x4 wg[3], wv[3];
#pragma unroll
            for (int j = 0; j < 3; ++j) { wg[j] = *(const f32x4*)(cw + (size_t)j * FF2 + ch); wv[j] = *(const f32x4*)(cw + (size_t)j * FF2 + FF + ch); }
            const f32x4 bg = *(const f32x4*)(cb + ch), bv = *(const f32x4*)(cb + FF + ch);
#pragma unroll
            for (int ai = 0; ai < 2; ++ai) { const int seg = 2 * ai + wr;
                f32x4 xp[2], xn[2];
#pragma unroll
                for (int bj = 0; bj < 2; ++bj) {
                    xp[bj] = seg > 0 ? *(const LAS f32x4*)(xch + (((((seg - 1) * 4 + wc) * 2 + 1) * 2 + bj) * 2 + n) * 16 + 4 * fq) : (f32x4){0.f, 0.f, 0.f, 0.f};
                    xn[bj] = seg < 3 ? *(const LAS f32x4*)(xch + (((((seg + 1) * 4 + wc) * 2 + 0) * 2 + bj) * 2 + n) * 16 + 4 * fq) : (f32x4){0.f, 0.f, 0.f, 0.f}; }
#pragma unroll
                for (int m = 0; m < 4; ++m) {
                    f32x4 uc[2];
#pragma unroll
                    for (int bj = 0; bj < 2; ++bj) {
                        const f32x4 cur = acc[ai][bj][m][n]; f32x4 pv, nx;
#pragma unroll
                        for (int e = 0; e < 4; ++e) {
                            const float oldp = m == 0 ? xp[bj][e] : dpp_ror1(acc[ai][bj][m == 0 ? 0 : m - 1][n][e]);
                            const float oldn = m == 3 ? xn[bj][e] : dpp_ror15(acc[ai][bj][m == 3 ? 3 : m + 1][n][e]);
                            pv[e] = dpp_shr1_old(oldp, cur[e]); nx[e] = dpp_shl1_old(oldn, cur[e]); }
                        const f32x4 w0 = bj == 0 ? wg[0] : wv[0], w1 = bj == 0 ? wg[1] : wv[1], w2 = bj == 0 ? wg[2] : wv[2], bb = bj == 0 ? bg : bv;
                        uc[bj] = w0 * pv + w1 * cur + w2 * nx + bb; }
                    f32x4 o;
#pragma unroll
                    for (int e = 0; e < 4; ++e) o[e] = siluf_(uc[0][e]) * uc[1][e];
                    const int row = u.pm * 256 + ai * 128 + wr * 64 + m * 16 + fr;
                    *(u32x2*)(act + (size_t)row * PF + ch) = f32_to_bf4(o); } }
        }
    }
};
struct EpiRwkv1 {
    bf16_t* rkv; bf16_t* l1;
    __device__ __forceinline__ void operator()(EPI_ARGS) const {
        const int cl = wc * 32 + 4 * fq; const int sub = u.sub;
        bf16_t* base; int ldc;
        if (sub < 3) { base = rkv + (size_t)sub * M * PK + u.pnl * 256 + cl; ldc = PK; } else { base = l1 + (sub - 3) * 256 + cl; ldc = PL1; }
#pragma unroll
        for (int ai = 0; ai < 2; ++ai)
#pragma unroll
            for (int m = 0; m < 4; ++m) {
                const int row = u.pm * 256 + ai * 128 + wr * 64 + m * 16 + fr; bf16_t* op = base + (size_t)row * ldc;
#pragma unroll
                for (int bj = 0; bj < 2; ++bj)
#pragma unroll
                    for (int n = 0; n < 2; ++n) { f32x4 v = acc[ai][bj][m][n];
                        if (sub == 3) { v.x = tanhf_(v.x); v.y = tanhf_(v.y); v.z = tanhf_(v.z); v.w = tanhf_(v.w); }
                        else if (sub == 5) { v.x = sigmoidf_(v.x); v.y = sigmoidf_(v.y); v.z = sigmoidf_(v.z); v.w = sigmoidf_(v.w); }
                        *(u32x2*)(op + bj * 128 + n * 16) = f32_to_bf4(v); }
            }
    }
};
struct EpiRwkv2 {
    float* dec; bf16_t* aa; bf16_t* g; const float* w0; const float* a0;
    __device__ __forceinline__ void operator()(EPI_ARGS) const {
        const int sub = u.sub; const int e = (sub < 2) ? (u.pnl >> 3) : 0; const int col0 = ((sub < 2) ? (u.pnl & 7) : u.pnl) * 256 + wc * 32 + 4 * fq;
        f32x4 bv[2][2];
#pragma unroll
        for (int bj = 0; bj < 2; ++bj)
#pragma unroll
            for (int n = 0; n < 2; ++n) bv[bj][n] = sub == 0 ? *(const f32x4*)(w0 + e * DM + col0 + bj * 128 + n * 16) : (sub == 1 ? *(const f32x4*)(a0 + e * DM + col0 + bj * 128 + n * 16) : (f32x4){0.f, 0.f, 0.f, 0.f});
#pragma unroll
        for (int ai = 0; ai < 2; ++ai)
#pragma unroll
            for (int m = 0; m < 4; ++m) {
                const int row = u.pm * 256 + ai * 128 + wr * 64 + m * 16 + fr; const size_t off = ((size_t)e * M + row) * PK + col0;
#pragma unroll
                for (int bj = 0; bj < 2; ++bj)
#pragma unroll
                    for (int n = 0; n < 2; ++n) { f32x4 v = acc[ai][bj][m][n] + bv[bj][n];
                        if (sub == 0) { v.x = __expf(-0.606531f * sigmoidf_(v.x)); v.y = __expf(-0.606531f * sigmoidf_(v.y)); v.z = __expf(-0.606531f * sigmoidf_(v.z)); v.w = __expf(-0.606531f * sigmoidf_(v.w));
                            *(f32x4*)(dec + off + bj * 128 + n * 16) = v; }
                        else if (sub == 1) { v.x = sigmoidf_(v.x); v.y = sigmoidf_(v.y); v.z = sigmoidf_(v.z); v.w = sigmoidf_(v.w); *(u32x2*)(aa + off + bj * 128 + n * 16) = f32_to_bf4(v); }
                        else *(u32x2*)(g + off + bj * 128 + n * 16) = f32_to_bf4(v); }
            }
    }
};

struct Args { const float* in[N_IN]; float* out; unsigned char* ws; int ph_lo, ph_hi; };

__device__ __forceinline__ void transpose_item(const float* src, int ld_src, int Kvalid, int k0, int n0, bf16_t* dst, int ld_dst, int drow0, int dcol0, LAS float* scr, int lane) {
#pragma unroll 8
    for (int i = 0; i < 32; ++i) { const int kk = 2 * i + (lane >> 5); scr[kk * 33 + (lane & 31)] = (k0 + kk < Kvalid) ? src[(size_t)(k0 + kk) * ld_src + n0 + (lane & 31)] : 0.f; }
    asm volatile("s_waitcnt lgkmcnt(0)" ::: "memory");
    const int c = lane & 7;
#pragma unroll
    for (int j = 0; j < 4; ++j) { const int n = (lane >> 3) + 8 * j; const LAS float* s = scr + (8 * c) * 33 + n;
        u32x4 o; o.x = pk2(s[0 * 33], s[1 * 33]); o.y = pk2(s[2 * 33], s[3 * 33]); o.z = pk2(s[4 * 33], s[5 * 33]); o.w = pk2(s[6 * 33], s[7 * 33]);
        if (k0 + 8 * c < Kvalid) *(u32x4*)(dst + (size_t)(drow0 + n) * ld_dst + dcol0 + k0 + 8 * c) = o; }
    asm volatile("s_waitcnt lgkmcnt(0)" ::: "memory");
}

__device__ __forceinline__ void transpose_item64(const float* src, int ld_src, int Kvalid, int k0, int n0, bf16_t* dst, int ld_dst, int drow0, int dcol0, LAS unsigned* scr, int lane) {
    const int n4 = lane & 15, kr = lane >> 4;
    const f32x4 z = {0.f, 0.f, 0.f, 0.f};
#pragma unroll
    for (int it = 0; it < 8; ++it) { const int k = k0 + 8 * it + 2 * kr; const float* p = src + (size_t)k * ld_src + n0 + 4 * n4;
        const f32x4 a = (k < Kvalid) ? *(const f32x4*)p : z, b = (k + 1 < Kvalid) ? *(const f32x4*)(p + ld_src) : z;
#pragma unroll
        for (int j = 0; j < 4; ++j) scr[(4 * n4 + j) * 33 + 4 * it + kr] = pk2(a[j], b[j]); }
    asm volatile("s_waitcnt lgkmcnt(0)" ::: "memory");
    const int c = lane & 7;
#pragma unroll
    for (int jj = 0; jj < 8; ++jj) { const int n = (lane >> 3) + 8 * jj; const LAS unsigned* s = scr + n * 33 + 4 * c;
        u32x4 o; o.x = s[0]; o.y = s[1]; o.z = s[2]; o.w = s[3];
        if (k0 + 8 * c < Kvalid) *(u32x4*)(dst + (size_t)(drow0 + n) * ld_dst + dcol0 + k0 + 8 * c) = o; }
    asm volatile("s_waitcnt lgkmcnt(0)" ::: "memory");
}

__device__ __forceinline__ void convert_weights(const Args& A, LAS unsigned char* lds, int set, int part, int gw, int NGW) {
    const int tid = opaque_tid(), lane = tid & 63, wave = tid >> 6;
    unsigned char* ws = A.ws;
    LAS float* scr = (LAS float*)(lds + wave * 16384);
    LAS unsigned* scu = (LAS unsigned*)(lds + wave * 16384);
    constexpr int NI_UPL = 32 * 176, NI_DNL = 88 * 32, NI_PL = 8 * 8, NI_SQ = 32 * 32, NI_L1 = 32 * 3, NI_G1 = 32 * 4, NI_L2 = 2 * 32, NI_G2 = 4 * 32, NI_Q = 32 * 48;
    const int l = set;
    const int nextra = (set == 0 || set == 3) ? 4 * NI_PL : (set == 1 ? 4 * NI_SQ + 4 * NI_L1 + NI_G1 + 4 * NI_L2 + NI_G2 : NI_Q + NI_SQ);
    const int lo = part == 2 ? NI_UPL + NI_DNL : 0, nitems = part == 1 ? NI_UPL + NI_DNL : NI_UPL + NI_DNL + nextra;
    for (int it = lo + gw; it < nitems; it += NGW) {
        int r = it;
        if (r < NI_UPL) { const int kb = r / 176, nb = r % 176, n0 = nb * 64;
            const int drow0 = n0 < FF ? (n0 >> 7) * 256 + (n0 & 127) : ((n0 - FF) >> 7) * 256 + 128 + ((n0 - FF) & 127);
            transpose_item64(A.in[I_UP] + (size_t)l * DM * FF2, FF2, DM, kb * 64, n0, (bf16_t*)(ws + WS_WUP + l * SZ_UP), PK, drow0, 0, scu, lane); continue; }
        r -= NI_UPL;
        if (r < NI_DNL) { const int kb = r / 32, nb = r % 32;
            transpose_item64(A.in[I_DOWN] + (size_t)l * FF * DM, DM, FF, kb * 64, nb * 64, (bf16_t*)(ws + WS_WDN + l * SZ_DN), PF, nb * 64, 0, scu, lane); continue; }
        r -= NI_DNL;
        if (set == 0 || set == 3) { const int sg = (set == 0 ? 0 : 4) + r / NI_PL; r %= NI_PL; const int kb = r / 8, nb = r % 8;
            transpose_item64(A.in[I_POOLW] + (size_t)sg * 512 * 512, 512, 512, kb * 64, nb * 64, (bf16_t*)(ws + WS_WPOOL) + (size_t)sg * 512 * PPW, PPW, nb * 64, 0, scu, lane); continue; }
        if (set == 1) {
            if (r < 4 * NI_SQ) { const int w = r / NI_SQ; r %= NI_SQ; const int kb = r / 32, nb = r % 32; const int idx = w == 0 ? I_WR : (w == 1 ? I_WK : (w == 2 ? I_WV : I_WO));
                transpose_item64(A.in[idx], DM, DM, kb * 64, nb * 64, (bf16_t*)(ws + WS_WR + w * SZ_SQ), PK, nb * 64, 0, scu, lane); continue; }
            r -= 4 * NI_SQ;
            if (r < 4 * NI_L1) { const int we = r / NI_L1; r %= NI_L1; const int which = we >> 1, e = we & 1, kb = r / 3, nb = r % 3;
                transpose_item(A.in[which ? I_A1 : I_W1] + (size_t)e * DM * 96, 96, DM, kb * 64, nb * 32, (bf16_t*)(ws + WS_WL1), PK, which * 256 + e * 128 + nb * 32, 0, scr, lane); continue; }
            r -= 4 * NI_L1;
            if (r < NI_G1) { const int kb = r / 4, nb = r % 4;
                transpose_item64(A.in[I_G1], 256, DM, kb * 64, nb * 64, (bf16_t*)(ws + WS_WL1), PK, 512 + nb * 64, 0, scu, lane); continue; }
            r -= NI_G1;
            if (r < 4 * NI_L2) { const int we = r / NI_L2; r %= NI_L2; const int which = we >> 1, e = we & 1, kb = r / 32, nb = r % 32;
                transpose_item64(A.in[which ? I_A2 : I_W2] + (size_t)e * 96 * DM, DM, 96, kb * 64, nb * 64, (bf16_t*)(ws + (which ? WS_WA2 : WS_WW2)), PW2, e * DM + nb * 64, 0, scu, lane); continue; }
            r -= 4 * NI_L2;
            { const int kb = r / 32, nb = r % 32;
                transpose_item64(A.in[I_G2], DM, 256, kb * 64, nb * 64, (bf16_t*)(ws + WS_WG2), PW2, nb * 64, 0, scu, lane); continue; }
        }
        if (r < NI_Q) { const int kb = r / 48, nb = r % 48;
            transpose_item64(A.in[I_QKV], 3072, DM, kb * 64, nb * 64, (bf16_t*)(ws + WS_WQKV), PK, nb * 64, 0, scu, lane); continue; }
        r -= NI_Q;
        { const int kb = r / 32, nb = r % 32;
            transpose_item64(A.in[I_AO], DM, DM, kb * 64, nb * 64, (bf16_t*)(ws + WS_WAO), PK, nb * 64, 0, scu, lane); }
    }
}

__device__ __forceinline__ void phase_prologue(const Args& A, LAS unsigned char* lds) {
    const int tid = opaque_tid(), lane = tid & 63, wave = tid >> 6, G = gridDim.x, bx = blockIdx.x;
    unsigned char* ws = A.ws;
    for (int rep_ = 0; rep_ < REP_ADA; ++rep_) {
        LAS float* sl = (LAS float*)lds;
        LAS float* red = (LAS float*)(lds + 73728);
        const float* cc = A.in[I_C]; const float* cctx = A.in[I_CCTX];
        for (int i = tid; i < NCOND * DM; i += NTHREADS) { const int r = i / DM, k = i % DM; const float c = r == 0 ? cctx[k] : cc[(r - 1) * DM + k]; sl[k * 9 + r] = siluf_(c); }
        __syncthreads();
        float* mod = (float*)(ws + WS_MOD);
        for (int item = bx; item < 4 * 192; item += G) {
            const int l = item / 192, n0 = (item % 192) * 64;
            const float* W = A.in[I_ADAW] + (size_t)l * DM * MODW + n0 + (lane & 15) * 4;
            const int kr = tid >> 4;
            f32x4 acc[9];
#pragma unroll
            for (int r = 0; r < 9; ++r) acc[r] = (f32x4){0.f, 0.f, 0.f, 0.f};
#pragma unroll 8
            for (int k = kr; k < DM; k += 32) { const f32x4 w = *(const f32x4*)(W + (size_t)k * MODW);
#pragma unroll
                for (int r = 0; r < 9; ++r) acc[r] += sl[k * 9 + r] * w; }
#pragma unroll
            for (int r = 0; r < 9; ++r)
#pragma unroll
                for (int j = 0; j < 4; ++j) { float v = acc[r][j]; v += __shfl_xor(v, 16); v += __shfl_xor(v, 32); acc[r][j] = v; }
            if (lane < 16) {
#pragma unroll
                for (int r = 0; r < 9; ++r) *(LAS f32x4*)(red + (wave * 9 + r) * 64 + lane * 4) = acc[r];
            }
            __syncthreads();
            for (int o = tid; o < 9 * 64; o += NTHREADS) { const int r = o >> 6, c = o & 63; float s = 0.f;
#pragma unroll
                for (int w = 0; w < 8; ++w) s += red[(w * 9 + r) * 64 + c];
                mod[((size_t)l * 9 + r) * MODW + n0 + c] = s + A.in[I_ADAB][l * MODW + n0 + c]; }
            __syncthreads();
        }
    }
    __syncthreads();
    for (int rep_ = 0; rep_ < REP_TR; ++rep_) {
        const int gw = bx * NWAVES + wave, NGW = G * NWAVES;
        convert_weights(A, lds, 0, 0, gw, NGW);
        convert_weights(A, lds, 1, 2, gw, NGW);
        float* rowsq0 = (float*)(ws + WS_RSQ);
        for (int m = gw; m < M; m += NGW) {
            const float* src = m < M_P ? A.in[I_XP] + (size_t)m * DM : A.in[I_XS] + (size_t)(m - M_P) * DM; float ss = 0.f;
#pragma unroll
            for (int j = 0; j < 8; ++j) { const f32x4 v = *(const f32x4*)(src + 4 * lane + 256 * j); ss += (v.x * v.x + v.y * v.y) + (v.z * v.z + v.w * v.w); }
            ss = wave_sum(ss);
            if (lane == 0) rowsq0[m] = ss;
        }
    }
    {
        const int gt = bx * NTHREADS + tid, NT = G * NTHREADS; const u32x4 z4 = {0u, 0u, 0u, 0u};
        constexpr int PCS = PK * 2 / 16;
        for (int i = gt; i < 4 * 32 * PCS; i += NT) { const int blk = i / (32 * PCS), r = (i / PCS) % 32, pc = i % PCS;
            *(u32x4*)(ws + WS_WL1 + (size_t)(blk * 128 + 96 + r) * PK * 2 + pc * 16) = z4; }
        for (int i = gt; i < 2 * 4096 * 4; i += NT) { const int row = i >> 2, pc = i & 3;
            *(u32x4*)(ws + WS_WW2 + ((size_t)row * PW2 + 96) * 2 + pc * 16) = z4; }
    }
    {
        constexpr int NV = 8 * 512 * 512 / 8;
        for (int i = bx * NTHREADS + tid; i < 2 * NV; i += G * NTHREADS) {
            const bool isv = i >= NV; const int j = isv ? i - NV : i;
            const float* s = A.in[isv ? I_CV : I_CK] + (size_t)j * 8; const f32x4 a = *(const f32x4*)s, b = *(const f32x4*)(s + 4);
            u32x4 o; o.x = pk2(a.x, a.y); o.y = pk2(a.z, a.w); o.z = pk2(b.x, b.y); o.w = pk2(b.z, b.w);
            *(u32x4*)((bf16_t*)(ws + (isv ? WS_CVB : WS_CKB)) + (size_t)j * 8) = o;
        }
    }
}

__device__ __forceinline__ void phase_normmod(const bf16_t* xb, RowSq rowsq, const float* gain, const float* mod_sh, const float* mod_sc, bf16_t* out) {
    const int tid_ = opaque_tid(), lane = tid_ & 63, gw = blockIdx.x * NWAVES + (tid_ >> 6), NGW = gridDim.x * NWAVES;
    const int rpw = ((M + NGW - 1) / NGW + 1) & ~1;
    const int m_lo = gw * rpw, m_hi = min(M, m_lo + rpw);
    int ccur = -1; f32x4 G[4][2], S1[4][2], S0[4][2];
    for (int m = m_lo; m < m_hi; m += 2) {
        const float p0 = lane < rowsq.n ? rowsq.p[(size_t)lane * M + m] : 0.f, p1 = lane < rowsq.n ? rowsq.p[(size_t)lane * M + m + 1] : 0.f;
        u32x4 xa[4], xc[4];
#pragma unroll
        for (int j = 0; j < 4; ++j) { xa[j] = *(const u32x4*)(xb + (size_t)m * PK + 8 * lane + 512 * j); xc[j] = *(const u32x4*)(xb + (size_t)(m + 1) * PK + 8 * lane + 512 * j); }
#pragma unroll
        for (int h = 0; h < 2; ++h) {
            const int mm = m + h, cond = cond_of_row(mm);
            if (cond != ccur) { ccur = cond;
#pragma unroll
                for (int j = 0; j < 4; ++j)
#pragma unroll
                    for (int u = 0; u < 2; ++u) { const int c = 8 * lane + 512 * j + 4 * u; G[j][u] = *(const f32x4*)(gain + c); S1[j][u] = 1.f + *(const f32x4*)(mod_sc + (size_t)cond * MODW + c); S0[j][u] = *(const f32x4*)(mod_sh + (size_t)cond * MODW + c); } }
            const float rstd = rsqrtf(wave_sum(h == 0 ? p0 : p1) * (1.f / DM) + NORM_EPS);
            bf16_t* o = out + (size_t)mm * PK;
#pragma unroll
            for (int j = 0; j < 4; ++j) { const u32x4 w = h == 0 ? xa[j] : xc[j];
                const f32x4 lo = bf4_to_f32((u32x2){w.x, w.y}), hi = bf4_to_f32((u32x2){w.z, w.w});
                const u32x2 a = f32_to_bf4((lo * rstd * G[j][0]) * S1[j][0] + S0[j][0]), b = f32_to_bf4((hi * rstd * G[j][1]) * S1[j][1] + S0[j][1]);
                *(u32x4*)(o + 8 * lane + 512 * j) = (u32x4){a.x, a.y, b.x, b.y}; }
        }
    }
}
__device__ __forceinline__ void rows_rstd(RowSq rowsq, int sb, int T, int tfirst, int NR, LAS float* rs, int tid) {
    const int i = tid >> 3, j = tid & 7, t = tfirst + i;
    const int tc = min(max(t, 0), T - 1), m = sb + tc;
    float s = 0.f;
#pragma unroll
    for (int q = 0; q < RSQ_PARTS / 8; ++q) { const int idx = j + 8 * q; s += idx < rowsq.n ? rowsq.p[(size_t)idx * M + m] : 0.f; }
    s = DPP_ADD(s, 0xB1); s = DPP_ADD(s, 0x4E); s = DPP_ADD(s, 0x141);
    if (j == 0 && i < NR) rs[i] = rsqrtf(s * (1.f / DM) + NORM_EPS);
}

template <int GI>
__device__ __forceinline__ void pool_item(const float* x_lo, const float* x_hi, const bf16_t* xb, RowSq rowsq, const float* gain, const float* mod_sh, const float* mod_sc, bf16_t* out, LAS float* tile, LAS float* rs, int chunk, int c) {
    constexpr int WIN = 2 << GI, LEFT = WIN >> 1, RIGHT = WIN - 1 - LEFT, R0 = 8 - LEFT, NRW = 32 + LEFT + RIGHT;
    const int m0 = chunk * 32;
    int sb, T; if (m0 < M_P) { sb = m0 & ~(T_P - 1); T = T_P; } else { sb = M_P + ((m0 - M_P) & ~(T_S - 1)); T = T_S; }
    const int t0 = m0 - sb, cond = cond_of_row(m0), col = GI * 512 + c;
    rows_rstd(rowsq, sb, T, t0 - 8, 48, rs, c);
    constexpr int NJ = (NRW + 3) / 4;
    const int c4 = (c & 127) * 4, rsub = c >> 7, col4 = GI * 512 + c4;
    const f32x4 g4 = *(const f32x4*)(gain + col4), s14 = 1.f + *(const f32x4*)(mod_sc + (size_t)cond * MODW + col4), s04 = *(const f32x4*)(mod_sh + (size_t)cond * MODW + col4);
    f32x4 xv[NJ];
#pragma unroll
    for (int j = 0; j < NJ; ++j) { const int i = rsub + 4 * j, t = t0 - LEFT + i, tc = min(max(t, 0), T - 1), m = sb + tc;
        xv[j] = xb ? bf4_to_f32(*(const u32x2*)(xb + (size_t)m * PK + col4)) : *(const f32x4*)(m < M_P ? x_lo + (size_t)m * DM + col4 : x_hi + (size_t)(m - M_P) * DM + col4); }
    __syncthreads();
    const f32x4 zero4 = {0.f, 0.f, 0.f, 0.f};
#pragma unroll
    for (int j = 0; j < NJ; ++j) { const int i = rsub + 4 * j, t = t0 - LEFT + i;
        if (i < NRW) *(LAS f32x4*)(tile + (R0 + i) * 512 + c4) = (t >= 0 && t < T) ? xv[j] * rs[R0 + i] * g4 * s14 + s04 : zero4; }
    __syncthreads();
    float s = 0.f;
#pragma unroll
    for (int j = 0; j < WIN; ++j) s += tile[(R0 + j) * 512 + c];
#pragma unroll 4
    for (int i = 0; i < 32; ++i) { const int t = t0 + i, lo = max(t - LEFT, 0), hi = min(t + RIGHT + 1, T);
        const float o = s * __builtin_amdgcn_rcpf((float)(hi - lo)) - tile[(8 + i) * 512 + c];
        out[(size_t)(sb + t) * PK + col] = (bf16_t)f2bf(o);
        if (i < 31) s += tile[(8 + i + RIGHT + 1) * 512 + c] - tile[(8 + i - LEFT) * 512 + c]; }
    __syncthreads();
}
__device__ __forceinline__ void phase_pool_elem(const float* x_lo, const float* x_hi, const bf16_t* xb, RowSq rowsq, const float* gain, const float* mod_sh, const float* mod_sc, bf16_t* out, LAS unsigned char* lds) {
    LAS float* tile = (LAS float*)lds;
    LAS float* rs = (LAS float*)(lds + 48 * 512 * 4);
    const int c = opaque_tid();
    const int NI = (M / 32) * 4, G = gridDim.x; const bool xl = (G & 7) == 0 && (NI % G) == 0;
    const int nrnd = (NI + G - 1) / G;
    for (int rnd = 0; rnd < nrnd; ++rnd) {
        int item = (int)blockIdx.x + rnd * G; if (item >= NI) break;
        if (xl) { const int x = blockIdx.x & 7, j = blockIdx.x >> 3, per = NI / 8, wpx = G / 8; item = x * per + rnd * wpx + j; }
        const int chunk = item >> 2, gi = item & 3;
        if (gi == 0) pool_item<0>(x_lo, x_hi, xb, rowsq, gain, mod_sh, mod_sc, out, tile, rs, chunk, c);
        else if (gi == 1) pool_item<1>(x_lo, x_hi, xb, rowsq, gain, mod_sh, mod_sc, out, tile, rs, chunk, c);
        else if (gi == 2) pool_item<2>(x_lo, x_hi, xb, rowsq, gain, mod_sh, mod_sc, out, tile, rs, chunk, c);
        else pool_item<3>(x_lo, x_hi, xb, rowsq, gain, mod_sh, mod_sc, out, tile, rs, chunk, c);
    }
}

__device__ __forceinline__ void phase_conv_fix(const float* halo, const float* cw, const float* cb, bf16_t* act) {
    const int tid = opaque_tid();
    for (int i = blockIdx.x * NTHREADS + tid; i < 56 * (FF / 4); i += gridDim.x * NTHREADS) {
        const int bd = i / (FF / 4), c = (i % (FF / 4)) * 4, tA = 16 + 8 * (bd / 7) + (bd % 7), tB = tA + 1;
        const int ug = (c >> 7) * 256 + (c & 127);
        f32x4 wg[3], wv[3];
#pragma unroll
        for (int j = 0; j < 3; ++j) { wg[j] = *(const f32x4*)(cw + (size_t)j * FF2 + c); wv[j] = *(const f32x4*)(cw + (size_t)j * FF2 + FF + c); }
        const f32x4 bg = *(const f32x4*)(cb + c), bv = *(const f32x4*)(cb + FF + c);
        const float* hA = halo + (size_t)tA * 4 * FF2 + ug; const float* hB = halo + (size_t)tB * 4 * FF2 + ug;
        const f32x4 g254 = *(const f32x4*)(hA + 2 * FF2), g255 = *(const f32x4*)(hA + 3 * FF2), g0 = *(const f32x4*)(hB), g1 = *(const f32x4*)(hB + FF2);
        const f32x4 v254 = *(const f32x4*)(hA + 2 * FF2 + 128), v255 = *(const f32x4*)(hA + 3 * FF2 + 128), v0 = *(const f32x4*)(hB + 128), v1 = *(const f32x4*)(hB + FF2 + 128);
        const f32x4 uga = wg[0] * g254 + wg[1] * g255 + wg[2] * g0 + bg, uva = wv[0] * v254 + wv[1] * v255 + wv[2] * v0 + bv;
        const f32x4 ugb = wg[0] * g255 + wg[1] * g0 + wg[2] * g1 + bg, uvb = wv[0] * v255 + wv[1] * v0 + wv[2] * v1 + bv;
        f32x4 oa, ob;
#pragma unroll
        for (int e2 = 0; e2 < 4; ++e2) { oa[e2] = siluf_(uga[e2]) * uva[e2]; ob[e2] = siluf_(ugb[e2]) * uvb[e2]; }
        *(u32x2*)(act + ((size_t)tA * 256 + 255) * PF + c) = f32_to_bf4(oa);
        *(u32x2*)(act + ((size_t)tB * 256) * PF + c) = f32_to_bf4(ob);
    }
}

__device__ __forceinline__ void phase_rwkv_shift(const bf16_t* xb, RowSq rowsq, const float* gain, const float* mod_sh, const float* mod_sc, const float* mu, bf16_t* X6, LAS unsigned char* lds) {
    LAS float* rs = (LAS float*)lds;
    const int tid = opaque_tid(), c = 4 * tid;
    for (int item = blockIdx.x; item < M / 16; item += gridDim.x) {
        const int m0 = item * 16; int sb, T; if (m0 < M_P) { sb = m0 & ~(T_P - 1); T = T_P; } else { sb = M_P + ((m0 - M_P) & ~(T_S - 1)); T = T_S; }
        const int t0 = m0 - sb, cond = cond_of_row(m0);
        __syncthreads();
        rows_rstd(rowsq, sb, T, t0 - 1, 18, rs, tid);
        f32x4 xv[18];
#pragma unroll
        for (int i = 0; i < 18; ++i) { const int t = t0 - 1 + i, tc = min(max(t, 0), T - 1); xv[i] = bf4_to_f32(*(const u32x2*)(xb + (size_t)(sb + tc) * PK + c)); }
        const f32x4 g = *(const f32x4*)(gain + c), s1 = 1.f + *(const f32x4*)(mod_sc + (size_t)cond * MODW + c), s0 = *(const f32x4*)(mod_sh + (size_t)cond * MODW + c);
        f32x4 muv[6];
#pragma unroll
        for (int i = 0; i < 6; ++i) muv[i] = *(const f32x4*)(mu + i * DM + c);
        __syncthreads();
        const f32x4 zero = {0.f, 0.f, 0.f, 0.f};
#pragma unroll
        for (int i = 0; i < 18; ++i) { const int t = t0 - 1 + i; xv[i] = (t >= 0 && t < T) ? (xv[i] * rs[i] * g) * s1 + s0 : zero; }
#pragma unroll
        for (int i = 0; i < 16; ++i) { const f32x4 hc = xv[i + 1], xx = 0.5f * (xv[i] + xv[i + 2]) - hc; const size_t off = (size_t)(m0 + i) * PK + c;
#pragma unroll
            for (int k = 0; k < 6; ++k) *(u32x2*)(X6 + (size_t)k * M * PK + off) = f32_to_bf4(hc + xx * muv[k]); }
    }
}

__device__ __forceinline__ float dpp_ror4(float x)  { return __builtin_bit_cast(float, __builtin_amdgcn_update_dpp(0, __builtin_bit_cast(int, x), 0x124, 0xF, 0xF, true)); }
__device__ __forceinline__ float dpp_ror12(float x) { return __builtin_bit_cast(float, __builtin_amdgcn_update_dpp(0, __builtin_bit_cast(int, x), 0x12C, 0xF, 0xF, true)); }
__device__ __forceinline__ void phase_qk_norm_rope(bf16_t* QKV, const float* qn, const float* kn, float* out_ck, float* out_cv, LAS unsigned char* lds) {
    const int tid = opaque_tid(), lane = tid & 63, gw = blockIdx.x * NWAVES + (tid >> 6), NGW = gridDim.x * NWAVES;
    LAS f32x2* tab = (LAS f32x2*)lds;
    for (int o = tid; o < 64 * 32; o += NTHREADS) { const int pos = o >> 5, i = o & 31; float sn, cs; sincosf((float)pos * exp2f(-(float)i * (13.287712379549449f / 32.f)), &sn, &cs); tab[o] = (f32x2){cs, sn}; }
    __syncthreads();
    const int li = lane & 15, g4 = lane >> 4, axis = li >> 3, ib = (li & 3) * 8;
    const bool hi_half = (li & 4) != 0;
    f32x4 qw[2], kw[2];
#pragma unroll
    for (int u = 0; u < 2; ++u) { qw[u] = *(const f32x4*)(qn + 8 * li + 4 * u); kw[u] = *(const f32x4*)(kn + 8 * li + 4 * u); }
    for (int m = gw; m < M; m += NGW) {
        const bool samp = m >= M_P; bf16_t* row = QKV + (size_t)m * PQ + 8 * lane;
        u32x4 ch[6];
#pragma unroll
        for (int j = 0; j < 6; ++j) ch[j] = *(const u32x4*)(row + 512 * j);
        f32x2 cs8[8];
        if (samp) { const int t = (m - M_P) & (T_S - 1), pos = axis == 0 ? (t >> 6) : (t & 63);
#pragma unroll
            for (int e2 = 0; e2 < 8; ++e2) cs8[e2] = tab[pos * 32 + ib + e2]; }
#pragma unroll
        for (int j = 0; j < 5; ++j) {
            float xv[8];
#pragma unroll
            for (int p = 0; p < 4; ++p) { xv[2 * p] = bflo(ch[j][p]); xv[2 * p + 1] = bfhi(ch[j][p]); }
            float ss = 0.f;
#pragma unroll
            for (int e2 = 0; e2 < 8; ++e2) ss += xv[e2] * xv[e2];
            const float rstd = rsqrtf(row16_sum(ss) * (1.f / 128.f) + NORM_EPS);
#pragma unroll
            for (int e2 = 0; e2 < 8; ++e2) xv[e2] *= rstd * (j < 4 ? qw[e2 >> 2][e2 & 3] : kw[e2 >> 2][e2 & 3]);
            if (!samp && j == 4) { float* ck = out_ck + (size_t)m * 512 + g4 * 128 + 8 * li;
                *(f32x4*)ck = (f32x4){xv[0], xv[1], xv[2], xv[3]}; *(f32x4*)(ck + 4) = (f32x4){xv[4], xv[5], xv[6], xv[7]}; }
            if (samp) {
#pragma unroll
                for (int e2 = 0; e2 < 8; ++e2) { const float pa = __shfl_xor(xv[e2], 4);
                    xv[e2] = xv[e2] * cs8[e2].x + (hi_half ? pa : -pa) * cs8[e2].y; } }
            u32x4 w; w.x = pk2(xv[0], xv[1]); w.y = pk2(xv[2], xv[3]); w.z = pk2(xv[4], xv[5]); w.w = pk2(xv[6], xv[7]);
            *(u32x4*)(row + 512 * j) = w;
        }
        if (!samp) { float* cv = out_cv + (size_t)m * 512 + g4 * 128 + 8 * li;
            *(f32x4*)cv = (f32x4){bflo(ch[5].x), bfhi(ch[5].x), bflo(ch[5].y), bfhi(ch[5].y)}; *(f32x4*)(cv + 4) = (f32x4){bflo(ch[5].z), bfhi(ch[5].z), bflo(ch[5].w), bfhi(ch[5].w)}; }
    }
}

__device__ __forceinline__ float dpp_xor1(float x) { return __builtin_bit_cast(float, __builtin_amdgcn_update_dpp(0, __builtin_bit_cast(int, x), 0xB1, 0xF, 0xF, true)); }
__device__ __forceinline__ float dpp_xor2(float x) { return __builtin_bit_cast(float, __builtin_amdgcn_update_dpp(0, __builtin_bit_cast(int, x), 0x4E, 0xF, 0xF, true)); }

struct ScanArgs { const bf16_t* R; const bf16_t* Kb; const bf16_t* V; const float* DEC; const bf16_t* AA; const bf16_t* Gt; bf16_t* OFB; bf16_t* Y;
                  const float* state_in; float* state_out; const float* k_k; const float* k_a; const float* r_k; const float* ln_w; const float* ln_b; };

typedef __bf16 bf16x2_t_ __attribute__((ext_vector_type(2)));
__device__ __forceinline__ unsigned cvt_pk_bf16_(float lo, float hi) { const f32x2 v = {lo, hi}; const bf16x2_t_ b = __builtin_convertvector(v, bf16x2_t_); return __builtin_bit_cast(unsigned, b); }
__device__ __forceinline__ bf16x8 mk8(unsigned x, unsigned y, unsigned z, unsigned w) { u32x4 t = {x, y, z, w}; return __builtin_bit_cast(bf16x8, t); }
__device__ __forceinline__ bf16x8 mk4(u32x2 x) { return mk8(x.x, x.y, 0u, 0u); }
__device__ __forceinline__ bf16x8 mk44(u32x2 x, u32x2 y) { return mk8(x.x, x.y, y.x, y.y); }
__device__ __forceinline__ f32x4 mma(bf16x8 a, bf16x8 b, f32x4 c) { return __builtin_amdgcn_mfma_f32_16x16x32_bf16(a, b, c, 0, 0, 0); }
__device__ __forceinline__ f32x4 mma16(u32x2 a, u32x2 b, f32x4 c) { return __builtin_amdgcn_mfma_f32_16x16x16bf16_1k(__builtin_bit_cast(s16x4, a), __builtin_bit_cast(s16x4, b), c, 0, 0, 0); }
__device__ __forceinline__ void st_to_bf16(const f32x4 (&St)[4], bf16x8& s0, bf16x8& s1) {
    s0 = mk8(cvt_pk_bf16_(St[0].x, St[0].y), cvt_pk_bf16_(St[0].z, St[0].w), cvt_pk_bf16_(St[1].x, St[1].y), cvt_pk_bf16_(St[1].z, St[1].w));
    s1 = mk8(cvt_pk_bf16_(St[2].x, St[2].y), cvt_pk_bf16_(St[2].z, St[2].w), cvt_pk_bf16_(St[3].x, St[3].y), cvt_pk_bf16_(St[3].z, St[3].w));
}
constexpr int TKP = 144;
constexpr int CH_WRAW = 0, CH_AT = 4096, CH_RT = CH_AT + 16 * TKP, CH_BT = CH_RT + 16 * TKP, CH_KT = CH_BT + 16 * TKP;
constexpr int KSP = 36;
constexpr int CH_BHK = CH_KT + 16 * TKP, CH_KHK = CH_BHK + 64 * KSP, CH_VT = CH_KHK + 64 * KSP, CH_GC = CH_VT + 64 * KSP, CH_GA = CH_GC + 256, CH_DIAG = CH_GA + 2048, CH_BYTES = ((CH_DIAG + 512 + 511) / 512) * 512;
static_assert(4 * CH_BYTES <= 131072 && CH_GC % 16 == 0 && CH_GA % 16 == 0 && CH_DIAG % 16 == 0, "scan LDS");
__device__ __forceinline__ u32x2 lds_ld2(const LAS unsigned char* p) { const LAS unsigned* q = (const LAS unsigned*)p; return (u32x2){q[0], q[1]}; }
#define SCAN_BAR() do { asm volatile("s_waitcnt lgkmcnt(0)" ::: "memory"); __builtin_amdgcn_s_barrier(); asm volatile("" ::: "memory"); } while (0)

__device__ __forceinline__ void phase_scan(const ScanArgs& S, LAS unsigned char* lds) {
    const int tid = opaque_tid(), dir = tid >> 8, lt = tid & 255, wv = lt >> 6, lane = tid & 63, i16 = lane & 15, v = i16 + 16 * wv, q = lane >> 4;
    const int ps = lt >> 4, kg = lt & 15;
    const int swv = __builtin_amdgcn_readfirstlane(wv);
    for (int i = tid; i < 4 * 12 * 64; i += NTHREADS) *(LAS float*)(lds + (i / 768) * CH_BYTES + CH_WRAW + (i % 768) * 4) = 1.f;
    __syncthreads();
    for (int it = blockIdx.x; it < 256 + 512; it += gridDim.x) {
        const bool samp = it < 256; int b, h, T, row0;
        if (samp) { b = it >> 5; h = it & 31; T = T_S; row0 = M_P + b * T_S; } else { const int j = it - 256; b = j >> 5; h = j & 31; T = T_P; row0 = b * T_P; }
        f32x4 St[4];
        if (samp) { const float* sp = S.state_in + ((size_t)((b * 2 + dir) * 32 + h)) * 4096 + v * 64 + 4 * q;
#pragma unroll
            for (int kt = 0; kt < 4; ++kt) St[kt] = *(const f32x4*)(sp + 16 * kt); }
        else {
#pragma unroll
            for (int kt = 0; kt < 4; ++kt) St[kt] = (f32x4){0.f, 0.f, 0.f, 0.f}; }
        bf16x8 sb0, sb1; st_to_bf16(St, sb0, sb1);
        const int hc = h * 64 + 4 * kg;
        const f32x4 kkw = *(const f32x4*)(S.k_k + hc), kaw = *(const f32x4*)(S.k_a + hc);
        const int nchunk = T / 16;
        struct PF { u32x2 r, k, v, a; f32x4 w; };
        const int sdir = __builtin_amdgcn_readfirstlane(dir);
        const char* pR = (const char*)S.R; const char* pK = (const char*)S.Kb; const char* pV = (const char*)S.V;
        const char* pA = (const char*)(S.AA + (size_t)sdir * M * PK); const char* pW = (const char*)(S.DEC + (size_t)sdir * M * PK);
        const int cstep = (sdir == 0 ? 16 : -16) * PK * 2;
        unsigned poff = (unsigned)(((row0 + (dir == 0 ? ps : T - 1 - ps)) * PK + hc) * 2);
        auto prefetch = [&](PF& p) {
            p.r = *(const u32x2*)(pR + poff); p.k = *(const u32x2*)(pK + poff); p.v = *(const u32x2*)(pV + poff);
            p.a = *(const u32x2*)(pA + poff); p.w = *(const f32x4*)(pW + 2u * poff); poff += (unsigned)cstep; };
        f32x4 gmask;
#pragma unroll
        for (int r = 0; r < 4; ++r) { const int j = 4 * q + r, t = i16; gmask[r] = (wv == 0 ? (q < (t >> 2)) : (wv == 1 ? (j < t) : (j <= t))) ? 1.f : 0.f; }
        PF pfA, pfB;
        prefetch(pfA); prefetch(pfB);
        char* pO = (char*)(S.OFB + (size_t)sdir * M * PK);
        const int rstep = (sdir == 0 ? 1 : -1) * PK * 2;
        unsigned ooff = (unsigned)(((row0 + (dir == 0 ? 4 * q : T - 1 - 4 * q)) * PK + h * 64 + v) * 2);
        auto do_chunk = [&](int c, PF& pf) {
            LAS unsigned char* B = lds + ((c & 1) * 2 + dir) * CH_BYTES;
            const f32x4 r4 = bf4_to_f32(pf.r), k4 = bf4_to_f32(pf.k), v4 = bf4_to_f32(pf.v), a4 = bf4_to_f32(pf.a), w4 = pf.w;
            const f32x4 kv = k4 * kkw; float ss = (kv.x * kv.x + kv.y * kv.y) + (kv.z * kv.z + kv.w * kv.w);
            ss = row16_sum(ss);
            const float inv = fminf(__builtin_amdgcn_rsqf(ss), 1e12f);
            const f32x4 kk = kv * inv, kd = k4 * (1.f + (a4 - 1.f) * kaw), bb = kk * a4;
            f32x4 inc = w4, exw;
            {
                const f32x4 one = {1.f, 1.f, 1.f, 1.f}; f32x4 t;
#pragma unroll
                for (int e = 0; e < 4; ++e) t[e] = __shfl_up(inc[e], 16);
                inc *= (lane >= 16) ? t : one;
#pragma unroll
                for (int e = 0; e < 4; ++e) t[e] = __shfl_up(inc[e], 32);
                inc *= (lane >= 32) ? t : one;
#pragma unroll
                for (int e = 0; e < 4; ++e) t[e] = __shfl_up(inc[e], 16);
                exw = (lane >= 16) ? t : one;
                if (lane >= 48) {
                    for (int d = swv + 1; d < 4; ++d) *(LAS f32x4*)(B + CH_WRAW + (d * 3 + wv) * 256 + 16 * kg) = inc; }
            }
#pragma unroll
            for (int e = 0; e < 4; ++e) *(LAS bf16_t*)(B + CH_VT + (4 * kg + e) * KSP + 2 * ps) = (bf16_t)((e < 2 ? pf.v.x : pf.v.y) >> (16 * (e & 1)));
            SCAN_BAR();
            if (c + 2 < nchunk) prefetch(pf);
            {
                f32x4 wt[3];
#pragma unroll
                for (int u = 0; u < 3; ++u) wt[u] = *(const LAS f32x4*)(B + CH_WRAW + (wv * 3 + u) * 256 + 16 * kg);
                const f32x4 gp = ((exw * wt[0]) * wt[1]) * wt[2];
                const f32x4 g = gp * w4;
                f32x4 ig; ig.x = __builtin_amdgcn_rcpf(g.x); ig.y = __builtin_amdgcn_rcpf(g.y); ig.z = __builtin_amdgcn_rcpf(g.z); ig.w = __builtin_amdgcn_rcpf(g.w);
                const f32x4 ah = -kk * gp, bh = bb * ig, kh = kd * ig, rh = r4 * g;
                *(LAS u32x2*)(B + CH_AT + ps * TKP + 8 * kg) = f32_to_bf4(ah);
                *(LAS u32x2*)(B + CH_RT + ps * TKP + 8 * kg) = f32_to_bf4(rh);
                const u32x2 bhb = f32_to_bf4(bh), khb = f32_to_bf4(kh);
                *(LAS u32x2*)(B + CH_BT + ps * TKP + 8 * kg) = bhb;
                *(LAS u32x2*)(B + CH_KT + ps * TKP + 8 * kg) = khb;
                LAS unsigned char* pb = B + CH_BHK + (4 * kg) * KSP + 2 * ps; LAS unsigned char* pkh = B + CH_KHK + (4 * kg) * KSP + 2 * ps;
                *(LAS bf16_t*)(pb) = (bf16_t)(bhb.x & 0xffffu); *(LAS bf16_t*)(pb + KSP) = (bf16_t)(bhb.x >> 16); *(LAS bf16_t*)(pb + 2 * KSP) = (bf16_t)(bhb.y & 0xffffu); *(LAS bf16_t*)(pb + 3 * KSP) = (bf16_t)(bhb.y >> 16);
                *(LAS bf16_t*)(pkh) = (bf16_t)(khb.x & 0xffffu); *(LAS bf16_t*)(pkh + KSP) = (bf16_t)(khb.x >> 16); *(LAS bf16_t*)(pkh + 2 * KSP) = (bf16_t)(khb.y & 0xffffu); *(LAS bf16_t*)(pkh + 3 * KSP) = (bf16_t)(khb.y >> 16);
                if (ps == 15) *(LAS f32x4*)(B + CH_GC + 16 * kg) = g;
            }
            SCAN_BAR();
            {
                const LAS unsigned char* X = B + ((wv & 1) ? CH_KT : CH_BT) + i16 * TKP + 16 * q; const LAS unsigned char* Y = B + ((wv >> 1) ? CH_RT : CH_AT) + i16 * TKP + 16 * q;
                f32x4 d = {0.f, 0.f, 0.f, 0.f};
                d = mma(*(const LAS bf16x8*)X, *(const LAS bf16x8*)Y, d);
                d = mma(*(const LAS bf16x8*)(X + 64), *(const LAS bf16x8*)(Y + 64), d);
                const int t = i16;
                if (wv == 0) {
                    LAS float* dg = (LAS float*)(B + CH_DIAG) + (q == (t >> 2) ? (q * 16 + (t & 3)) : 64 + lane);
#pragma unroll
                    for (int r = 0; r < 4; ++r) dg[q == (t >> 2) ? 4 * r : 0] = d[r]; }
                *(LAS u32x2*)(B + CH_GA + (wv * 64 + lane) * 8) = f32_to_bf4(d * gmask);
            }
            SCAN_BAR();
            {
                const LAS unsigned char* pa_ = B + CH_AT + i16 * TKP + 8 * q; const LAS unsigned char* pr_ = B + CH_RT + i16 * TKP + 8 * q;
                const bf16x8 zA0 = mk44(*(const LAS u32x2*)(pa_), *(const LAS u32x2*)(pa_ + 32)), zA1 = mk44(*(const LAS u32x2*)(pa_ + 64), *(const LAS u32x2*)(pa_ + 96));
                const bf16x8 rA0 = mk44(*(const LAS u32x2*)(pr_), *(const LAS u32x2*)(pr_ + 32)), rA1 = mk44(*(const LAS u32x2*)(pr_ + 64), *(const LAS u32x2*)(pr_ + 96));
                const f32x4 zero = {0.f, 0.f, 0.f, 0.f};
                f32x4 Z = mma(zA0, sb0, zero); Z = mma(zA1, sb1, Z);
                f32x4 O = mma(rA0, sb0, zero); O = mma(rA1, sb1, O);
                const u32x2 Bv = lds_ld2(B + CH_VT + v * KSP + 8 * q);
                const u32x2 gab = *(const LAS u32x2*)(B + CH_GA + (0 * 64 + lane) * 8), gka = *(const LAS u32x2*)(B + CH_GA + (1 * 64 + lane) * 8);
                const u32x2 gbr = *(const LAS u32x2*)(B + CH_GA + (2 * 64 + lane) * 8), gkr = *(const LAS u32x2*)(B + CH_GA + (3 * 64 + lane) * 8);
                Z = mma16(gka, Bv, Z);
                const f32x4 d0 = *(const LAS f32x4*)(B + CH_DIAG + (q * 4 + 0) * 16), d1 = *(const LAS f32x4*)(B + CH_DIAG + (q * 4 + 1) * 16), d2 = *(const LAS f32x4*)(B + CH_DIAG + (q * 4 + 2) * 16);
                f32x4 U = Z;
                U.y += d0.y * U.x; U.z += d0.z * U.x + d1.z * U.y; U.w += d0.w * U.x + d1.w * U.y + d2.w * U.z;
#pragma unroll
                for (int Q = 1; Q < 4; ++Q) {
                    U = mma16(gab, (u32x2){cvt_pk_bf16_(U.x, U.y), cvt_pk_bf16_(U.z, U.w)}, Z);
                    U.y += d0.y * U.x; U.z += d0.z * U.x + d1.z * U.y; U.w += d0.w * U.x + d1.w * U.y + d2.w * U.z;
                }
                const u32x2 Ub = {cvt_pk_bf16_(U.x, U.y), cvt_pk_bf16_(U.z, U.w)};
                O = mma16(gbr, Ub, O); O = mma16(gkr, Bv, O);
#pragma unroll
                for (int r = 0; r < 4; ++r) *(bf16_t*)(pO + (ooff + (unsigned)(r * rstep))) = (bf16_t)f2bf(O[r]);
                ooff += (unsigned)cstep;
#pragma unroll
                for (int kt = 0; kt < 4; ++kt) {
                    const u32x2 abh = lds_ld2(B + CH_BHK + (16 * kt + i16) * KSP + 8 * q), akh = lds_ld2(B + CH_KHK + (16 * kt + i16) * KSP + 8 * q);
                    f32x4 s = mma16(abh, Ub, St[kt]); s = mma16(akh, Bv, s);
                    St[kt] = s * *(const LAS f32x4*)(B + CH_GC + 4 * (16 * kt + 4 * q)); }
                st_to_bf16(St, sb0, sb1);
            }
        };
        for (int c = 0; c < nchunk; c += 2) { do_chunk(c, pfA); do_chunk(c + 1, pfB); }
        if (!samp) { float* sp = S.state_out + ((size_t)((b * 2 + dir) * 32 + h)) * 4096 + v * 64 + 4 * q;
#pragma unroll
            for (int kt = 0; kt < 4; ++kt) *(f32x4*)(sp + 16 * kt) = St[kt]; }
        asm volatile("s_waitcnt vmcnt(0)" ::: "memory");
        __syncthreads();
        {
            const int tk = tid >> 4, hc2 = h * 64 + 4 * (tid & 15);
            const f32x4 lw = *(const f32x4*)(S.ln_w + hc2), lb = *(const f32x4*)(S.ln_b + hc2), ka = *(const f32x4*)(S.k_a + hc2), rk = *(const f32x4*)(S.r_k + hc2);
            struct OS { u32x2 of, ob, r, k, v, af, ab, g; };
            auto os_load = [&](size_t off) { OS q; q.of = *(const u32x2*)(S.OFB + off); q.ob = *(const u32x2*)(S.OFB + (size_t)M * PK + off); q.r = *(const u32x2*)(S.R + off); q.k = *(const u32x2*)(S.Kb + off);
                q.v = *(const u32x2*)(S.V + off); q.af = *(const u32x2*)(S.AA + off); q.ab = *(const u32x2*)(S.AA + (size_t)M * PK + off); q.g = *(const u32x2*)(S.Gt + off); return q; };
            auto os_finish = [&](const OS& q, size_t off) {
                const f32x4 o = bf4_to_f32(q.of) + bf4_to_f32(q.ob);
                const float mean = row16_sum((o.x + o.y) + (o.z + o.w)) * (1.f / 64.f);
                const f32x4 d = o - mean;
                const float var = row16_sum((d.x * d.x + d.y * d.y) + (d.z * d.z + d.w * d.w)) * (1.f / 64.f);
                const f32x4 on = d * rsqrtf(var + 64e-5f) * lw + lb;
                const f32x4 r4 = bf4_to_f32(q.r), k4 = bf4_to_f32(q.k), v4 = bf4_to_f32(q.v);
                const f32x4 af = bf4_to_f32(q.af), ab = bf4_to_f32(q.ab), g4 = bf4_to_f32(q.g);
                const f32x4 kds = k4 * ((1.f + (af - 1.f) * ka) + (1.f + (ab - 1.f) * ka));
                const f32x4 pr4 = r4 * kds * rk;
                const float bon = row16_sum((pr4.x + pr4.y) + (pr4.z + pr4.w));
                *(u32x2*)(S.Y + off) = f32_to_bf4((on + bon * v4) * g4); };
            for (int t = tk; t < T; t += 64) {
                const size_t off0 = (size_t)(row0 + t) * PK + hc2, off1 = off0 + (size_t)32 * PK;
                const OS q0 = os_load(off0), q1 = os_load(off1);
                __builtin_amdgcn_sched_barrier(0);
                os_finish(q0, off0); os_finish(q1, off1); }
        }
        __syncthreads();
    }
}

namespace attn {
constexpr int D = 128, NW = 8, QBLK = 32, KVBLK = 64;
constexpr float SCALE = 0.088388347648318440f;
constexpr float THR = 8.f;
constexpr size_t SHM_V = KVBLK * D * 2, SHM_K = KVBLK * D * 2, SHM_ATTN = 2 * SHM_V + 2 * SHM_K + NW * 64 * 4;
#define KSWZ(row, colB) ((row) * 256 + ((colB) ^ (((row) & 7) << 4)))
#define SBAR() __builtin_amdgcn_sched_barrier(0)
__device__ __forceinline__ int crow(int r, int hi) { return (r & 3) + 8 * (r >> 2) + 4 * hi; }
__device__ __forceinline__ unsigned cvtpk(float lo, float hi) { unsigned r; asm volatile("v_cvt_pk_bf16_f32 %0, %1, %2" : "=v"(r) : "v"(lo), "v"(hi)); return r; }

__device__ __forceinline__ void partialSM(f32x16& p0, f32x16& p1, float& m_reg, float& mn, float& alpha) {
    constexpr float C = SCALE * 1.4426950408889634f;
    float pmax = p0[0];
#pragma unroll
    for (int r = 1; r < 16; ++r) pmax = fmaxf(pmax, p0[r]);
#pragma unroll
    for (int r = 0; r < 16; ++r) pmax = fmaxf(pmax, p1[r]);
    { auto rr = __builtin_amdgcn_permlane32_swap(__float_as_uint(pmax), __float_as_uint(pmax), false, false);
      pmax = fmaxf(__uint_as_float(rr[0]), __uint_as_float(rr[1])); }
    if (__builtin_expect(__all(pmax - m_reg <= THR / SCALE), 1)) { mn = m_reg; alpha = 1.f; }
    else { mn = fmaxf(m_reg, pmax); alpha = __builtin_amdgcn_exp2f((m_reg - mn) * C); m_reg = mn; }
    const float mnC = -mn * C;
#pragma unroll
    for (int r = 0; r < 16; ++r) p0[r] = fmaf(p0[r], C, mnC);
#pragma unroll
    for (int r = 0; r < 16; ++r) p1[r] = fmaf(p1[r], C, mnC);
#pragma unroll
    for (int r = 0; r < 16; ++r) p0[r] = __builtin_amdgcn_exp2f(p0[r]);
}
__device__ __forceinline__ void finishSM(f32x16& p0, f32x16& p1, float alpha, float& l_reg, bf16x8& pa0, bf16x8& pa1, bf16x8& pa2, bf16x8& pa3) {
#pragma unroll
    for (int r = 0; r < 16; ++r) p1[r] = __builtin_amdgcn_exp2f(p1[r]);
    float ps = 0;
#pragma unroll
    for (int r = 0; r < 16; ++r) ps += p0[r];
#pragma unroll
    for (int r = 0; r < 16; ++r) ps += p1[r];
    { auto rr = __builtin_amdgcn_permlane32_swap(__float_as_uint(ps), __float_as_uint(ps), false, false);
      ps = __uint_as_float(rr[0]) + __uint_as_float(rr[1]); }
    l_reg = l_reg * alpha + ps;
#define PK4(P, BASE, OUT) do { unsigned a0 = cvtpk(P[BASE + 0], P[BASE + 1]), a1 = cvtpk(P[BASE + 2], P[BASE + 3]);   \
    unsigned b0 = cvtpk(P[BASE + 4], P[BASE + 5]), b1 = cvtpk(P[BASE + 6], P[BASE + 7]);                              \
    auto r0 = __builtin_amdgcn_permlane32_swap(a0, b0, false, false); auto r1 = __builtin_amdgcn_permlane32_swap(a1, b1, false, false); \
    u32x4 w = {r0[0], r1[0], r0[1], r1[1]}; OUT = __builtin_bit_cast(bf16x8, w); } while (0)
    PK4(p0, 0, pa0); PK4(p0, 8, pa1); PK4(p1, 0, pa2); PK4(p1, 8, pa3);
#undef PK4
}
__device__ __forceinline__ void qkt(f32x16& p0, f32x16& p1, const LAS char* Ks, const bf16x8* qr, int r32, int hi) {
    p0 = f32x16{}; p1 = f32x16{};
#pragma unroll
    for (int d0 = 0; d0 < 8; ++d0) { const int cb = (d0 * 16 + hi * 8) * 2;
        const bf16x8 b0 = *(const LAS bf16x8*)(Ks + KSWZ(r32, cb));
        const bf16x8 b1 = *(const LAS bf16x8*)(Ks + KSWZ(32 + r32, cb));
        p0 = __builtin_amdgcn_mfma_f32_32x32x16_bf16(b0, qr[d0], p0, 0, 0, 0);
        p1 = __builtin_amdgcn_mfma_f32_32x32x16_bf16(b1, qr[d0], p1, 0, 0, 0); }
}
__device__ __forceinline__ void band_mask(f32x16& p0, f32x16& p1, int kt0, int qpos, int hi) {
#pragma unroll
    for (int r = 0; r < 16; ++r) { const int d0 = qpos - (kt0 + crow(r, hi)), d1 = d0 - 32;
        if (d0 > 128 || d0 < -128) p0[r] = -1e30f;
        if (d1 > 128 || d1 < -128) p1[r] = -1e30f; }
}
__device__ __forceinline__ int v_st(int k, int c) { const int kk = (k & ~0xC) | ((k & 4) << 1) | ((k & 8) >> 1); return ((kk >> 3) * 4 + (c >> 5)) * 512 + ((kk & 7) * 32 + (c & 31)) * 2; }
__device__ __forceinline__ int v_rd_base(int lane) { return ((lane & 3) << 3) | (((lane >> 2) & 3) << 6) | (((lane >> 4) & 1) << 5) | (((lane >> 5) & 1) << 8); }
constexpr int v_rd_off(int d0, int ks, int half) { return d0 * 512 + ks * 4096 + half * 2048; }
template <int OFF> __device__ __forceinline__ s16x4 tr_read(int vb) {
    s16x4 r; asm volatile("ds_read_b64_tr_b16 %0, %1 offset:%2" : "=&v"(r) : "v"(vb), "i"(OFF) : "memory"); return r;
}
template <int D0> __device__ __forceinline__ void pv_one(f32x16& od, int vb, bf16x8 pa0, bf16x8 pa1, bf16x8 pa2, bf16x8 pa3) {
    const s16x4 l0 = tr_read<v_rd_off(D0, 0, 0)>(vb), h0 = tr_read<v_rd_off(D0, 0, 1)>(vb), l1 = tr_read<v_rd_off(D0, 1, 0)>(vb), h1 = tr_read<v_rd_off(D0, 1, 1)>(vb);
    const s16x4 l2 = tr_read<v_rd_off(D0, 2, 0)>(vb), h2 = tr_read<v_rd_off(D0, 2, 1)>(vb), l3 = tr_read<v_rd_off(D0, 3, 0)>(vb), h3 = tr_read<v_rd_off(D0, 3, 1)>(vb);
    asm volatile("s_waitcnt lgkmcnt(0)" ::: "memory"); SBAR();
#define PK(L, H) (bf16x8){L[0], L[1], L[2], L[3], H[0], H[1], H[2], H[3]}
    od = __builtin_amdgcn_mfma_f32_32x32x16_bf16(pa0, PK(l0, h0), od, 0, 0, 0);
    od = __builtin_amdgcn_mfma_f32_32x32x16_bf16(pa1, PK(l1, h1), od, 0, 0, 0);
    od = __builtin_amdgcn_mfma_f32_32x32x16_bf16(pa2, PK(l2, h2), od, 0, 0, 0);
    od = __builtin_amdgcn_mfma_f32_32x32x16_bf16(pa3, PK(l3, h3), od, 0, 0, 0);
#undef PK
}
__device__ __forceinline__ void pv_d0(f32x16* o, int vb, bf16x8 pa0, bf16x8 pa1, bf16x8 pa2, bf16x8 pa3) {
    pv_one<0>(o[0], vb, pa0, pa1, pa2, pa3); pv_one<1>(o[1], vb, pa0, pa1, pa2, pa3); pv_one<2>(o[2], vb, pa0, pa1, pa2, pa3); pv_one<3>(o[3], vb, pa0, pa1, pa2, pa3);
}

struct UnitDesc {
    const bf16_t* q;
    const bf16_t* ctxK; const bf16_t* ctxV;
    const bf16_t* bandK; const bf16_t* bandV;
    bf16_t* o;
    int nctx, band_lo, nband, q0, masked, head0;
};

__device__ __forceinline__ void attn_unit(const UnitDesc& U, const float* sink, LAS char* lds) {
    const int tid = opaque_tid(), wid = tid >> 6, lane = tid & 63, r32 = lane & 31, hi = lane >> 5;
    LAS char* V_lds = lds; LAS char* K_lds = lds + 2 * SHM_V;
    LAS float* wsx = (LAS float*)(lds + 2 * SHM_V + 2 * SHM_K) + wid * 64; LAS float* li_l = wsx; LAS float* al_l = wsx + 32;
    float m_reg = -1e30f, l_reg = 0; f32x16 o[4] = {}; bf16x8 qr[8];
    const int head = U.head0 + (wid >> 2), qrow = 32 * (wid & 3) + r32, qpos = U.q0 + qrow;
    const bf16_t* Qw = U.q + (size_t)qrow * PQ + head * 128 + hi * 8;
#pragma unroll
    for (int d0 = 0; d0 < 8; ++d0) qr[d0] = *(const bf16x8*)(Qw + d0 * 16);
    const int sr = tid >> 4, sc = (tid & 15) * 8, vst0 = v_st(sr, sc), vst1 = v_st(32 + sr, sc);
    const int vb0 = (int)(unsigned)(uintptr_t)V_lds + v_rd_base(lane);
    bf16x8 s_vs0[2], s_vs1[2], s_ks0[2], s_ks1[2];
    const int NT = U.nctx + U.nband;
#define TSRC(j, kp, vp, ld) const bf16_t* kp; const bf16_t* vp; int ld; do { if ((j) < U.nctx) { kp = U.ctxK + (size_t)(j) * 64 * 512; vp = U.ctxV + (size_t)(j) * 64 * 512; ld = 512; } \
        else { const size_t _o = (size_t)(U.band_lo + ((j) - U.nctx) * 64) * PQ; kp = U.bandK + _o; vp = U.bandV + _o; ld = PQ; } } while (0)
#define SLOAD(i, j) do { TSRC(j, _kp, _vp, _ld); s_vs0[i] = *(const bf16x8*)(_vp + (size_t)sr * _ld + sc); s_vs1[i] = *(const bf16x8*)(_vp + (size_t)(32 + sr) * _ld + sc); \
        s_ks0[i] = *(const bf16x8*)(_kp + (size_t)sr * _ld + sc); s_ks1[i] = *(const bf16x8*)(_kp + (size_t)(32 + sr) * _ld + sc); } while (0)
#define SWRITE(b, i) do { *(LAS bf16x8*)(V_lds + (b) * SHM_V + vst0) = s_vs0[i]; *(LAS bf16x8*)(V_lds + (b) * SHM_V + vst1) = s_vs1[i]; const int kc = sc * 2; \
        *(LAS bf16x8*)(K_lds + (b) * SHM_K + KSWZ(sr, kc)) = s_ks0[i]; *(LAS bf16x8*)(K_lds + (b) * SHM_K + KSWZ(32 + sr, kc)) = s_ks1[i]; } while (0)
#define SWAIT() asm volatile("s_waitcnt vmcnt(4)" ::: "memory")
#define RESC(a) do { if (__any((a) < 1.f)) { if (hi == 0) al_l[r32] = (a); asm volatile("s_waitcnt lgkmcnt(0)" ::: "memory"); \
        _Pragma("unroll") for (int d = 0; d < 4; ++d) _Pragma("unroll") for (int r = 0; r < 16; ++r) o[d][r] *= al_l[crow(r, hi)]; } } while (0)
#define MASK(p0, p1, j) do { if (U.masked && (j) >= U.nctx) band_mask(p0, p1, U.band_lo + ((j) - U.nctx) * 64, qpos, hi); } while (0)
    f32x16 pA0, pA1, pB0, pB1; float mnA, mnB, alA, alB; bf16x8 pa0, pa1, pa2, pa3;
    constexpr int SE = 0, SO = 1;
    SLOAD(SE, 0); asm volatile("s_waitcnt vmcnt(0)" ::: "memory"); SWRITE(0, SE); __syncthreads();
    qkt(pA0, pA1, K_lds, qr, r32, hi); MASK(pA0, pA1, 0); partialSM(pA0, pA1, m_reg, mnA, alA);
    SLOAD(SO, 1); if (2 < NT) SLOAD(SE, 2);
    SWAIT(); SWRITE(1, SO); __syncthreads();
    for (int j = 1; j + 1 < NT; j += 2) {
        SBAR(); qkt(pB0, pB1, K_lds + SHM_K, qr, r32, hi); MASK(pB0, pB1, j);
        finishSM(pA0, pA1, alA, l_reg, pa0, pa1, pa2, pa3); SBAR();
        SLOAD(SO, j + 2); SBAR();
        pv_d0(o, vb0, pa0, pa1, pa2, pa3); partialSM(pB0, pB1, m_reg, mnB, alB);
        __syncthreads(); SWAIT(); SWRITE(0, SE);
        RESC(alB); __syncthreads();
        SBAR(); qkt(pA0, pA1, K_lds, qr, r32, hi); MASK(pA0, pA1, j + 1);
        finishSM(pB0, pB1, alB, l_reg, pa0, pa1, pa2, pa3); SBAR();
        if (j + 3 < NT) SLOAD(SE, j + 3); SBAR();
        pv_d0(o, vb0 + (int)SHM_V, pa0, pa1, pa2, pa3); partialSM(pA0, pA1, m_reg, mnA, alA);
        __syncthreads(); SWAIT(); SWRITE(1, SO);
        RESC(alA); __syncthreads();
    }
    SBAR(); qkt(pB0, pB1, K_lds + SHM_K, qr, r32, hi); MASK(pB0, pB1, NT - 1);
    finishSM(pA0, pA1, alA, l_reg, pa0, pa1, pa2, pa3); SBAR();
    pv_d0(o, vb0, pa0, pa1, pa2, pa3); partialSM(pB0, pB1, m_reg, mnB, alB);
    __syncthreads(); RESC(alB);
    finishSM(pB0, pB1, alB, l_reg, pa0, pa1, pa2, pa3); SBAR();
    pv_d0(o, vb0 + (int)SHM_V, pa0, pa1, pa2, pa3);
    l_reg += __builtin_amdgcn_exp2f(sink[head] * 1.4426950408889634f - m_reg * (SCALE * 1.4426950408889634f));
    if (hi == 0) li_l[r32] = l_reg; asm volatile("s_waitcnt lgkmcnt(0)" ::: "memory");
    float rli[16];
#pragma unroll
    for (int r = 0; r < 16; ++r) rli[r] = __builtin_amdgcn_rcpf(li_l[crow(r, hi)]);
    bf16_t* Ow = U.o + (size_t)(32 * (wid & 3)) * PK + head * 128;
#pragma unroll
    for (int r = 0; r < 16; ++r) { const int orow = crow(r, hi);
#pragma unroll
        for (int d0 = 0; d0 < 4; ++d0) Ow[(size_t)orow * PK + d0 * 32 + r32] = (bf16_t)f2bf(o[d0][r] * rli[r]); }
#undef TSRC
#undef SLOAD
#undef SWRITE
#undef SWAIT
#undef RESC
#undef MASK
}
}

__device__ __forceinline__ void phase_attention(const bf16_t* QKV, const bf16_t* CKB, const bf16_t* CVB, const float* sink, bf16_t* AO, LAS unsigned char* lds) {
    for (int un = blockIdx.x; un < 1024 + 256; un += gridDim.x) {
        attn::UnitDesc U;
        if (un < 1024) { const int hp = un & 1, qb = (un >> 1) & 15, g = (un >> 5) & 3, b = un >> 7; const int row0 = M_P + b * T_S, q0 = qb * 128;
            U.q = QKV + (size_t)(row0 + q0) * PQ; U.ctxK = CKB + ((size_t)b * 512 * 4 + g) * 128; U.ctxV = CVB + ((size_t)b * 512 * 4 + g) * 128;
            U.bandK = QKV + (size_t)row0 * PQ + 2048 + g * 128; U.bandV = QKV + (size_t)row0 * PQ + 2560 + g * 128; U.o = AO + (size_t)(row0 + q0) * PK;
            const int lo = max(q0 - 128, 0), hiq = min(q0 + 256, T_S);
            U.nctx = 8; U.band_lo = lo; U.nband = (hiq - lo) / 64; U.q0 = q0; U.masked = 1; U.head0 = 4 * g + 2 * hp; }
        else { const int j = un - 1024; const int hp = j & 1, qb = (j >> 1) & 1, g = (j >> 2) & 3, b = j >> 4; const int row0 = b * T_P, q0 = qb * 128;
            U.q = QKV + (size_t)(row0 + q0) * PQ; U.ctxK = nullptr; U.ctxV = nullptr;
            U.bandK = QKV + (size_t)row0 * PQ + 2048 + g * 128; U.bandV = QKV + (size_t)row0 * PQ + 2560 + g * 128; U.o = AO + (size_t)(row0 + q0) * PK;
            U.nctx = 0; U.band_lo = 0; U.nband = 4; U.q0 = q0; U.masked = 0; U.head0 = 4 * g + 2 * hp; }
        __syncthreads();
        attn::attn_unit(U, sink, (LAS char*)lds);
    }
}

constexpr int PH_PER_LAYER = 12, N_PHASES = 1 + 4 * PH_PER_LAYER;
__host__ __device__ constexpr int kind_of_layer(int l) { return l % 3; }
__host__ __device__ inline bool phase_active(int ph) {
    if (ph == 0) return true;
    const int l = (ph - 1) / PH_PER_LAYER, j = (ph - 1) % PH_PER_LAYER, kind = kind_of_layer(l);
    if (j >= 6) return j <= 9;
    return kind == 0 ? j <= 1 : j <= 4;
}

__global__ void __launch_bounds__(NTHREADS, 2) mega_fwd(Args A) {
    extern __shared__ __attribute__((aligned(16))) unsigned char lds_raw[];
    LAS unsigned char* lds = (LAS unsigned char*)lds_raw;
    const int tid = threadIdx.x;
    unsigned char* ws = A.ws;
    volatile LAS unsigned* misc = (volatile LAS unsigned*)(lds + LDS_MISC);
    if (tid < 4) misc[tid] = 0u;
    __syncthreads();
    const int lo = A.ph_lo, hi = A.ph_hi;
    const bool multi = (hi - lo) > 1;
    XcdBarrier bar; bar.bar = (unsigned*)(ws + WS_CTL) + CW_BAR; bar.x = 0; bar.st = misc;
    if (multi) bar = xcd_barrier_post((unsigned*)(ws + WS_CTL) + CW_BAR, misc);
#ifndef SEL_KIND
#define SITE(k, j) true
#else
#define SITE(k, j) ((SEL_KIND) == (k) && (SEL_J) == (j))
#endif
#define IN(k) (lo <= (k) && (k) < hi)
#define SEAM() do { if (multi) xcd_barrier(bar); } while (0)

    float* X = A.out + OUT_X;
    bf16_t* XB = (bf16_t*)(ws + WS_XB);
    float* rowsq = (float*)(ws + WS_RSQ);
    const float* mod = (const float*)(ws + WS_MOD);

    if (SITE(8, 0) && IN(0)) for (int rep_ = 0; rep_ < REP_PRO; ++rep_) { phase_prologue(A, lds); SEAM(); }

    for (int l = 0; l < 4; ++l) {
        const int base = 1 + PH_PER_LAYER * l, kind = kind_of_layer(l), slot = l / 3;
        const float* modl = mod + (size_t)l * NCOND * MODW;
        const RowSq rs_in{rowsq + (size_t)(2 * l) * RSQ_PARTS * M, l == 0 ? 1 : RSQ_PARTS}; float* rs_mid = rowsq + (size_t)(2 * l + 1) * RSQ_PARTS * M; float* rs_out = rowsq + (size_t)(2 * l + 2) * RSQ_PARTS * M;
        const float* nmix = A.in[I_NMIX] + l * DM; const float* nffn = A.in[I_NFFN] + l * DM;
        if (kind == 0) {
            if (SITE(0, 0) && IN(base + 0)) for (int rep_ = 0; rep_ < REP_ELEM; ++rep_) { phase_pool_elem(A.in[I_XP], A.in[I_XS], l == 0 ? nullptr : XB, rs_in, nmix, modl, modl + DM, (bf16_t*)(ws + WS_H), lds); SEAM(); }
            if (SITE(0, 1) && IN(base + 1)) {
                ProbPool P{(const bf16_t*)(ws + WS_H), (const bf16_t*)(ws + WS_WPOOL) + (size_t)slot * DM * PPW, PK, PPW, 512, M / 256, 8};
                EpiResid E{X, XB, modl + 2 * DM, A.in[I_POOLS] + slot * DM, rs_mid, A.in[I_XP], A.in[I_XS], l == 0 ? 0 : 1};
                pg8::gemm_phase<EpiResid, ProbPool, true, true>(lds, P, E);
                SEAM(); }
        } else if (kind == 1) {
            if (SITE(1, 0) && IN(base + 0)) for (int rep_ = 0; rep_ < REP_ELEM; ++rep_) { phase_rwkv_shift(XB, rs_in, nmix, modl, modl + DM, A.in[I_MU], (bf16_t*)(ws + WS_X6), lds); SEAM(); }
            if (SITE(1, 1) && IN(base + 1)) for (int rep_ = 0; rep_ < REP_RW; ++rep_) {
                ProbRwkv1 P{(const bf16_t*)(ws + WS_X6), (const bf16_t*)(ws + WS_WR), (const bf16_t*)(ws + WS_WL1), PK, PK, DM, M / 256, 27};
                EpiRwkv1 E{(bf16_t*)(ws + WS_RKV), (bf16_t*)(ws + WS_L1)};
                pg8::gemm_phase<EpiRwkv1, ProbRwkv1, true, true>(lds, P, E);
                SEAM(); }
            if (SITE(1, 2) && IN(base + 2)) for (int rep_ = 0; rep_ < REP_RW * REP_G2; ++rep_) {
                ProbRwkv2 P{(const bf16_t*)(ws + WS_L1), (const bf16_t*)(ws + WS_WW2), (const bf16_t*)(ws + WS_WA2), (const bf16_t*)(ws + WS_WG2), PL1, PW2, 256, M / 256, 40};
                EpiRwkv2 E{(float*)(ws + WS_DEC), (bf16_t*)(ws + WS_AA), (bf16_t*)(ws + WS_G), A.in[I_W0], A.in[I_A0]};
                pg8::gemm_phase<EpiRwkv2, ProbRwkv2, true, true>(lds, P, E);
                SEAM(); }
            if (SITE(1, 3) && IN(base + 3)) for (int rep_ = 0; rep_ < REP_SCAN; ++rep_) {
                ScanArgs S{(const bf16_t*)(ws + WS_RKV), (const bf16_t*)(ws + WS_RKV + SZ_H), (const bf16_t*)(ws + WS_RKV + 2 * SZ_H), (const float*)(ws + WS_DEC), (const bf16_t*)(ws + WS_AA),
                           (const bf16_t*)(ws + WS_G), (bf16_t*)(ws + WS_OFB), (bf16_t*)(ws + WS_Y), A.in[I_STATE], A.out + OUT_STATE, A.in[I_KK], A.in[I_KA], A.in[I_RK], A.in[I_LNW], A.in[I_LNB]};
                phase_scan(S, lds);
                SEAM(); }
        } else {
            if (SITE(2, 0) && IN(base + 0)) for (int rep_ = 0; rep_ < REP_ELEM; ++rep_) { phase_normmod(XB, rs_in, nmix, modl, modl + DM, (bf16_t*)(ws + WS_H)); SEAM(); }
            if (SITE(2, 1) && IN(base + 1)) {
                ProbSimple P{(const bf16_t*)(ws + WS_H), (const bf16_t*)(ws + WS_WQKV), PK, PK, DM, M / 256, 12};
                EpiBf16 E{(bf16_t*)(ws + WS_QKVB), PQ};
                pg8::gemm_phase<EpiBf16, ProbSimple, true, true>(lds, P, E);
                SEAM(); }
            if (SITE(2, 2) && IN(base + 2)) { phase_qk_norm_rope((bf16_t*)(ws + WS_QKVB), A.in[I_QN], A.in[I_KN], A.out + OUT_CK, A.out + OUT_CV, lds); SEAM(); }
            if (SITE(2, 3) && IN(base + 3)) for (int rep_ = 0; rep_ < REP_ATTN; ++rep_) { phase_attention((const bf16_t*)(ws + WS_QKVB), (const bf16_t*)(ws + WS_CKB), (const bf16_t*)(ws + WS_CVB), A.in[I_SINK], (bf16_t*)(ws + WS_AOB), lds); SEAM(); }
        }
        if (SITE(7, 4) && kind != 0 && IN(base + 4)) {
            ProbSimple P{(const bf16_t*)(ws + (kind == 1 ? WS_Y : WS_AOB)), (const bf16_t*)(ws + (kind == 1 ? WS_WR + 3 * SZ_SQ : WS_WAO)), PK, PK, DM, M / 256, 8};
            EpiResid E{X, XB, modl + 2 * DM, nullptr, rs_mid, nullptr, nullptr, 1};
            pg8::gemm_phase<EpiResid, ProbSimple, true, true>(lds, P, E);
            if (l == 1) { const int G = gridDim.x, rem = (M / 256 * 8) % G, bx = blockIdx.x;
                if (rem == 0) convert_weights(A, lds, 2, 2, bx * NWAVES + (opaque_tid() >> 6), G * NWAVES);
                else if (bx >= rem) convert_weights(A, lds, 2, 2, (bx - rem) * NWAVES + (opaque_tid() >> 6), (G - rem) * NWAVES); }
            SEAM(); }
        if (SITE(9, 6) && IN(base + 6)) for (int rep_ = 0; rep_ < REP_ELEM; ++rep_) { phase_normmod(XB, RowSq{rs_mid, RSQ_PARTS}, nffn, modl + 3 * DM, modl + 4 * DM, (bf16_t*)(ws + WS_H)); SEAM(); }
        if (SITE(9, 7) && IN(base + 7)) for (int rep_ = 0; rep_ < REP_UP; ++rep_) {
            ProbSimple P{(const bf16_t*)(ws + WS_H), (const bf16_t*)(ws + WS_WUP + (size_t)l * SZ_UP), PK, PK, DM, M / 256, FF2 / 256};
            EpiUpConv E{(bf16_t*)(ws + WS_ACTB), (float*)(ws + WS_U), A.in[I_CONVW] + (size_t)l * 3 * FF2, A.in[I_CONVB] + (size_t)l * FF2, (LAS float*)(lds + 131072)};
            pg8::gemm_phase<EpiUpConv, ProbSimple, true, true>(lds, P, E);
            SEAM(); }
        if (SITE(9, 8) && IN(base + 8)) for (int rep_ = 0; rep_ < REP_CONV; ++rep_) { phase_conv_fix((const float*)(ws + WS_U), A.in[I_CONVW] + (size_t)l * 3 * FF2, A.in[I_CONVB] + (size_t)l * FF2, (bf16_t*)(ws + WS_ACTB)); SEAM(); }
        if (SITE(9, 9) && IN(base + 9)) {
            ProbSimple P{(const bf16_t*)(ws + WS_ACTB), (const bf16_t*)(ws + WS_WDN + (size_t)l * SZ_DN), PF, PF, FF, M / 256, 8};
            EpiResid E{X, XB, modl + 5 * DM, nullptr, rs_out, nullptr, nullptr, l == 3 ? 2 : 1};
            pg8::gemm_phase<EpiResid, ProbSimple, true, true>(lds, P, E);
            if (l < 3) {
                const int G = gridDim.x, rem = (M / 256 * 8) % G, bx = blockIdx.x;
                const int part = l == 2 ? 0 : 1;
                if (rem == 0) convert_weights(A, lds, l + 1, part, bx * NWAVES + (opaque_tid() >> 6), G * NWAVES);
                else if (bx >= rem) convert_weights(A, lds, l + 1, part, (bx - rem) * NWAVES + (opaque_tid() >> 6), (G - rem) * NWAVES); }
            SEAM(); }
    }
#undef IN
#undef SEAM
}

extern "C" void kernel_launch(void* const* d_in, const int* in_sizes, int n_in, void* d_out, int out_size, void* d_ws, size_t ws_size, hipStream_t stream) {
    static int grid = 0;
    if (grid == 0) {
        if (n_in != N_IN || (size_t)out_size != OUT_TOTAL || ws_size < WS_END) {
            fprintf(stderr, "kernel_launch: built for %d inputs, %zu outputs, >= %zu bytes of workspace; got n_in %d, out %d, ws %zu; nothing launched\n", (int)N_IN, (size_t)OUT_TOTAL, (size_t)WS_END, n_in, out_size, ws_size);
            grid = -1; return; }
        int dev = 0, cus = 0, per_cu = 0;
        if (hipGetDevice(&dev) != hipSuccess || hipDeviceGetAttribute(&cus, hipDeviceAttributeMultiprocessorCount, dev) != hipSuccess) { fprintf(stderr, "kernel_launch: device query failed\n"); grid = -1; return; }
        if (hipFuncSetAttribute((const void*)mega_fwd, hipFuncAttributeMaxDynamicSharedMemorySize, LDS_BYTES) != hipSuccess) { fprintf(stderr, "kernel_launch: hipFuncSetAttribute failed\n"); grid = -1; return; }
        if (hipOccupancyMaxActiveBlocksPerMultiprocessor(&per_cu, (const void*)mega_fwd, NTHREADS, LDS_BYTES) != hipSuccess || per_cu < 1)
            fprintf(stderr, "kernel_launch: note: occupancy query reports %d workgroups per CU\n", per_cu);
        (void)hipGetLastError();
        grid = cus;
    }
    if (grid < 0) return;
    unsigned char* ws = (unsigned char*)d_ws;
    (void)hipMemsetAsync(ws + WS_CTL, 0, CTL_BYTES, stream);
    Args a{};
    for (int i = 0; i < N_IN; ++i) a.in[i] = (const float*)d_in[i];
    a.out = (float*)d_out; a.ws = ws;
#if MK_ONE_LAUNCH
    a.ph_lo = 0; a.ph_hi = N_PHASES;
    hipLaunchKernelGGL(mega_fwd, dim3(grid), dim3(NTHREADS), LDS_BYTES, stream, a);
#else
    for (int ph = 0; ph < MK_MAX_PHASE; ++ph) {
        if (!phase_active(ph)) continue;
        a.ph_lo = ph; a.ph_hi = ph + 1;
        hipLaunchKernelGGL(mega_fwd, dim3(grid), dim3(NTHREADS), LDS_BYTES, stream, a);
    }
#endif
    const hipError_t le = hipPeekAtLastError();
    if (le != hipSuccess) fprintf(stderr, "kernel_launch: launch failed: %s\n", hipGetErrorName(le));
}
```

```cpp
#include <hip/hip_runtime.h>
#include <cstdio>
#include <cstdint>

#ifndef MK_ONE_LAUNCH
#define MK_ONE_LAUNCH 1
#endif

#ifndef MK_MAX_PHASE
#define MK_MAX_PHASE 49
#endif

#ifndef REP_PRO
#define REP_PRO 1
#endif
#ifndef REP_ADA
#define REP_ADA 1
#endif
#ifndef REP_TR
#define REP_TR 1
#endif
#ifndef REP_UP
#define REP_UP 1
#endif
#ifndef REP_CONV
#define REP_CONV 1
#endif
#ifndef REP_SCAN
#define REP_SCAN 1
#endif
#ifndef REP_ATTN
#define REP_ATTN 1
#endif
#ifndef REP_RW
#define REP_RW 1
#endif
#ifndef REP_ELEM
#define REP_ELEM 1
#endif
#ifndef REP_G2
#define REP_G2 1
#endif

#define LAS __attribute__((address_space(3)))
#define GAS __attribute__((address_space(1)))
typedef unsigned short bf16_t;
typedef short bf16x8 __attribute__((ext_vector_type(8)));
typedef short s16x4 __attribute__((ext_vector_type(4)));
typedef float f32x4 __attribute__((ext_vector_type(4)));
typedef float f32x2 __attribute__((ext_vector_type(2)));
typedef float f32x16 __attribute__((ext_vector_type(16)));
typedef unsigned u32x4 __attribute__((ext_vector_type(4)));
typedef unsigned u32x2 __attribute__((ext_vector_type(2)));

constexpr int DM = 2048, FF = 5632, FF2 = 11264;
constexpr int NB_P = 16, T_P = 256, NB_S = 8, T_S = 2048;
constexpr int M_P = NB_P * T_P, M_S = NB_S * T_S, M = M_P + M_S;
constexpr int NCOND = 9, MODW = 6 * DM;
constexpr int NTHREADS = 512, NWAVES = 8;
constexpr float NORM_EPS = 1e-6f;
constexpr int PK = DM + 64;
constexpr int PF = FF + 64;
constexpr int PQ = 3072 + 64;
constexpr int PL1 = 768 + 64;
constexpr int PW2 = 256 + 64;
constexpr int PPW = 512 + 64;

enum { I_XP = 0, I_XS, I_STATE, I_CK, I_CV, I_C, I_CCTX, I_ADAW, I_ADAB, I_NMIX, I_NFFN, I_UP, I_CONVW, I_CONVB, I_DOWN, I_POOLW, I_POOLS,
       I_MU, I_WR, I_WK, I_WV, I_W0, I_W1, I_W2, I_A0, I_A1, I_A2, I_G1, I_G2, I_KK, I_KA, I_RK, I_LNW, I_LNB, I_WO,
       I_QKV, I_QN, I_KN, I_SINK, I_AO, N_IN };

constexpr size_t OUT_X = 0;
constexpr size_t OUT_STATE = (size_t)M * DM;
constexpr size_t OUT_CK = OUT_STATE + (size_t)16 * 2 * 32 * 4096;
constexpr size_t OUT_CV = OUT_CK + (size_t)16 * 256 * 512;
constexpr size_t OUT_TOTAL = OUT_CV + (size_t)16 * 256 * 512;

constexpr size_t MiB = 1u << 20;
constexpr size_t WS_CTL = 0, CTL_BYTES = 64 * 1024;
constexpr int CW_BAR = 1024;
constexpr size_t WS_MOD = 2 * MiB;
constexpr int RSQ_PARTS = 32;
constexpr size_t WS_RSQ = 4 * MiB, SZ_RSQ = (size_t)RSQ_PARTS * M * 4;
constexpr size_t WS_W = 28 * MiB;
constexpr size_t SZ_UP = (size_t)FF2 * PK * 2, SZ_DN = (size_t)DM * PF * 2, SZ_SQ = (size_t)DM * PK * 2;
constexpr size_t WS_WUP = WS_W;
constexpr size_t WS_WDN = WS_WUP + 4 * SZ_UP;
constexpr size_t WS_WPOOL = WS_WDN + 4 * SZ_DN;
constexpr size_t WS_WR = WS_WPOOL + 2 * (size_t)DM * PPW * 2;
constexpr size_t WS_WL1 = WS_WR + 4 * SZ_SQ;
constexpr size_t WS_WW2 = WS_WL1 + (size_t)768 * PK * 2;
constexpr size_t WS_WA2 = WS_WW2 + (size_t)4096 * PW2 * 2;
constexpr size_t WS_WG2 = WS_WA2 + (size_t)4096 * PW2 * 2;
constexpr size_t WS_WQKV = WS_WG2 + (size_t)2048 * PW2 * 2;
constexpr size_t WS_WAO = WS_WQKV + (size_t)3072 * PK * 2;
constexpr size_t WS_CKB = WS_WAO + SZ_SQ;
constexpr size_t WS_CVB = WS_CKB + (size_t)8 * 512 * 512 * 2;
constexpr size_t WS_ACT = ((WS_CVB + (size_t)8 * 512 * 512 * 2 + MiB - 1) / MiB) * MiB;
constexpr size_t SZ_H = (size_t)M * PK * 2;
constexpr size_t WS_H = WS_ACT;
constexpr size_t WS_U = WS_H + SZ_H;
constexpr size_t WS_ACTB = WS_U + 16 * MiB;
constexpr size_t WS_FFN_END = WS_ACTB + (size_t)M * PF * 2;
constexpr size_t WS_X6 = WS_ACT;
constexpr size_t WS_DEC = WS_X6, WS_AA = WS_DEC + (size_t)2 * M * PK * 4;
constexpr size_t WS_RKV = WS_X6 + 6 * SZ_H;
constexpr size_t WS_L1 = WS_RKV + 3 * SZ_H;
constexpr size_t WS_G = WS_L1 + (size_t)M * PL1 * 2;
constexpr size_t WS_OFB = WS_G + SZ_H;
constexpr size_t WS_Y = WS_RKV + 2 * SZ_H;
constexpr size_t WS_XB = WS_OFB + 2 * SZ_H;
constexpr size_t WS_RWKV_END = WS_XB + SZ_H;
constexpr size_t WS_QKVB = WS_ACT + SZ_H;
constexpr size_t WS_AOB = WS_QKVB + (size_t)M * PQ * 2;
constexpr size_t WS_END = WS_RWKV_END > WS_FFN_END ? WS_RWKV_END : WS_FFN_END;
static_assert(WS_AA + (size_t)2 * M * PK * 2 == WS_RKV, "DEC + AA overlay the six shifted inputs exactly");
static_assert((size_t)80 * 4 * FF2 * 4 <= 16 * MiB && WS_END <= 1536 * MiB, "halo rows fit their slot; the whole map fits the guaranteed workspace (4 x the largest input tensor)");

constexpr int LDS_BYTES = 147456;
constexpr int LDS_MISC = 131072 + 8192;

typedef __bf16 bf16x2_hw __attribute__((ext_vector_type(2)));
__device__ __forceinline__ unsigned pk2(float lo, float hi) { const f32x2 v = {lo, hi}; const bf16x2_hw b = __builtin_convertvector(v, bf16x2_hw); return __builtin_bit_cast(unsigned, b); }
__device__ __forceinline__ unsigned f2bf(float f) { return pk2(f, f) & 0xffffu; }
__device__ __forceinline__ float bf2f(unsigned short b) { return __builtin_bit_cast(float, ((unsigned)b) << 16); }
__device__ __forceinline__ float bflo(unsigned w) { return __builtin_bit_cast(float, w << 16); }
__device__ __forceinline__ float bfhi(unsigned w) { return __builtin_bit_cast(float, w & 0xffff0000u); }
__device__ __forceinline__ f32x4 bf4_to_f32(u32x2 w) { return (f32x4){bflo(w.x), bfhi(w.x), bflo(w.y), bfhi(w.y)}; }
__device__ __forceinline__ u32x2 f32_to_bf4(f32x4 v) { u32x2 w; w.x = pk2(v.x, v.y); w.y = pk2(v.z, v.w); return w; }
__device__ __forceinline__ float wave_sum(float v) {
#pragma unroll
    for (int o = 1; o < 64; o <<= 1) v += __shfl_xor(v, o);
    return v;
}
#define DPP_ADD(x, ctrl) ((x) + __builtin_bit_cast(float, __builtin_amdgcn_update_dpp(0, __builtin_bit_cast(int, (x)), (ctrl), 0xF, 0xF, true)))
__device__ __forceinline__ float row16_sum(float v) {
    v = DPP_ADD(v, 0xB1); v = DPP_ADD(v, 0x4E); v = DPP_ADD(v, 0x141); v = DPP_ADD(v, 0x140);
    return v;
}
__device__ __forceinline__ float sigmoidf_(float x) { return __builtin_amdgcn_rcpf(1.f + __expf(-x)); }
__device__ __forceinline__ float siluf_(float x) { return x * __builtin_amdgcn_rcpf(1.f + __expf(-x)); }
__device__ __forceinline__ float tanhf_(float x) { return 1.f - 2.f * __builtin_amdgcn_rcpf(1.f + __expf(2.f * x)); }
__device__ __forceinline__ int cond_of_row(int m) { return m < M_P ? 0 : 1 + ((m - M_P) >> 11); }
struct RowSq { const float* p; int n; };
__device__ __forceinline__ float rowsq_wave(RowSq r, int m, int lane) { const float v = lane < r.n ? r.p[(size_t)lane * M + m] : 0.f; return wave_sum(v); }
__device__ __forceinline__ float rowsq_seq(RowSq r, int m) { float s = 0.f; for (int i = 0; i < r.n; ++i) s += r.p[(size_t)i * M + m]; return s; }

__device__ __forceinline__ int opaque_tid() { int t = threadIdx.x; asm volatile("" : "+v"(t)); return t; }

#define XB_TMO      128
#define XB_XCNT(j)  (256  + 64 * (j))
#define XB_XSUB(j)  (1280 + 64 * (j))
#define XB_XGEN(j)  (2304 + 64 * (j))
#define XB_TOP      3328
#define XB_TOPGEN   3392
#define XCD_BAR_WORDS 3456
#define XB_SPIN_CAP (1u << 20)

__device__ __forceinline__ unsigned xb_ld(unsigned* p)              { return __hip_atomic_load(p, __ATOMIC_RELAXED, __HIP_MEMORY_SCOPE_AGENT); }
__device__ __forceinline__ unsigned xb_add(unsigned* p, unsigned v) { return __hip_atomic_fetch_add(p, v, __ATOMIC_RELAXED, __HIP_MEMORY_SCOPE_AGENT); }
__device__ __forceinline__ unsigned xb_xcc_id() { return (unsigned)__builtin_amdgcn_s_getreg((3 << 11) | 20) & 0xFu; }
#define XB_SPIN(cond, bar) do { unsigned _sp = 0; while (cond) { __builtin_amdgcn_s_sleep(1); \
    if ((++_sp & 255u) == 0u) { if (xb_ld(&(bar)[XB_TMO])) break; if (_sp > XB_SPIN_CAP) { atomicAdd(&(bar)[XB_TMO], 1u); break; } } } } while (0)

struct XcdBarrier { unsigned* bar; unsigned x; volatile LAS unsigned* st; };

__device__ __forceinline__ XcdBarrier xcd_barrier_post(unsigned* bar, volatile LAS unsigned* st) {
    XcdBarrier b; b.bar = bar; b.x = xb_xcc_id(); b.st = st;
    if (threadIdx.x == 0) (void)xb_add(&bar[XB_XCNT(b.x)], 1u);
    return b;
}
__device__ __forceinline__ void xcd_barrier_complete(unsigned* bar, unsigned x, unsigned& nloc, unsigned& nx) {
    const unsigned G = gridDim.x * gridDim.y * gridDim.z;
    unsigned sum, cnt, mine, sp = 0u;
    for (;;) {
        sum = 0u; cnt = 0u; mine = 0u;
#pragma unroll
        for (unsigned j = 0; j < 16; ++j) { const unsigned c = xb_ld(&bar[XB_XCNT(j)]); sum += c; cnt += (c > 0u) ? 1u : 0u; mine = (j == x) ? c : mine; }
        if (sum == G) break;
        __builtin_amdgcn_s_sleep(1);
        if ((++sp & 255u) == 0u) { if (xb_ld(&bar[XB_TMO])) break; if (sp > XB_SPIN_CAP) { atomicAdd(&bar[XB_TMO], 1u); break; } }
    }
    nloc = mine > 0u ? mine : 1u; nx = cnt > 0u ? cnt : 1u;
}
__device__ __forceinline__ void xcd_barrier(const XcdBarrier& b) {
    asm volatile("s_waitcnt vmcnt(0)" ::: "memory");
    __syncthreads();
    if (threadIdx.x == 0) {
        unsigned* bar = b.bar;
        __builtin_amdgcn_s_waitcnt(0);
        unsigned nloc = b.st[0], nx = b.st[1];
        if (nloc == 0u) { xcd_barrier_complete(bar, b.x, nloc, nx); b.st[0] = nloc; b.st[1] = nx; }
        const unsigned old = xb_add(&bar[XB_XSUB(b.x)], 1u);
        const unsigned gen = old / nloc;
        if (old + 1u == (gen + 1u) * nloc) {
            __builtin_amdgcn_fence(__ATOMIC_RELEASE, "agent");
            asm volatile("s_waitcnt vmcnt(0)" ::: "memory");
            const unsigned og = xb_add(&bar[XB_TOP], 1u);
            const unsigned tg = og / nx;
            if (og + 1u == (tg + 1u) * nx) xb_add(&bar[XB_TOPGEN], 1u);
            else XB_SPIN(xb_ld(&bar[XB_TOPGEN]) == tg, bar);
            __builtin_amdgcn_fence(__ATOMIC_ACQUIRE, "agent");
            xb_add(&bar[XB_XGEN(b.x)], 1u);
            asm volatile("s_waitcnt vmcnt(0)" ::: "memory");
        } else {
            XB_SPIN(xb_ld(&bar[XB_XGEN(b.x)]) == gen, bar);
            __builtin_amdgcn_fence(__ATOMIC_ACQUIRE, "agent");
            asm volatile("s_waitcnt vmcnt(0)" ::: "memory");
        }
    }
    __syncthreads();
}

namespace pg8 {
constexpr bool KALT = true;
constexpr int BM = 256, BK = 64, HALF = 128, HTB = HALF * BK * 2  , STAGE_BYTES = 8 * HTB, NXCD = 8, WGM = 8;

__host__ __device__ __forceinline__ int lds_byte(int r, int c) { const int st = (r >> 4) * 2 + (c >> 5), rr = r & 15, cc = c & 31, ob = rr * 64 + cc * 2; return st * 1024 + (ob ^ (((ob >> 9) & 1) << 5)); }
__host__ __device__ __forceinline__ void stage_rc(int b, int& R, int& C) { const int st = b / 1024, sb = b % 1024, swz = sb ^ (((sb >> 9) & 1) << 5); R = (st >> 1) * 16 + swz / 64; C = (st & 1) * 32 + (swz % 64) / 2; }

struct Unit { int pm, pn, sub, pnl, nt; const char* a; const char* b; };

struct TileOrder {
    int nM, nN, nwg, G, c;
    __device__ void init(int nM_, int nN_, int G_, int c_) { nM = nM_; nN = nN_; nwg = nM * nN; G = G_; c = c_; }
    __device__ bool next(int i, int& pm, int& pn) const {
        const long L = (long)i * G + c; if (L >= nwg) return false;
        int wgid = (int)L; { const int q = nwg / NXCD, r = nwg % NXCD, xcd = wgid % NXCD, off = wgid / NXCD; wgid = (xcd < r ? xcd * (q + 1) : r * (q + 1) + (xcd - r) * q) + off; }
        const int nig = WGM * nN, gid = wgid / nig, fm = gid * WGM, gsz = (nM - fm) < WGM ? (nM - fm) : WGM;
        pm = fm + ((wgid % nig) % gsz); pn = (wgid % nig) / gsz; return true;
    }
};

template <class Epi, class Prob, bool ALIGN_EPI, bool SP2>
__device__ __forceinline__ void gemm_phase(LAS unsigned char* lds, const Prob& P, const Epi& E) {
    const int tid = opaque_tid(), wid = __builtin_amdgcn_readfirstlane(tid >> 6), lane = tid & 63, wr = wid >> 2, wc = wid & 3, fr = lane & 15, fq = lane >> 4;
    const int K = P.K, nt = K / BK;
    TileOrder S; S.init(P.nM, P.nN, (int)gridDim.x, (int)blockIdx.x);
    unsigned voffA[2], voffB[2];
#pragma unroll
    for (int i = 0; i < 2; ++i) { int R, C; stage_rc(tid * 16 + i * 8192, R, C);
        voffA[i] = (unsigned)(R * P.lda + C) * 2u; voffB[i] = (unsigned)(R * P.ldb + C) * 2u; }
    const int kfwd = BK * 2;
    const size_t hstepA = (size_t)HALF * P.lda * 2, hstepB = (size_t)HALF * P.ldb * 2;
    const unsigned ldsw = (unsigned)wid * 1024u;
    const int aoff = lds_byte(wr * 64 + fr, fq * 8), boff = lds_byte(wc * 32 + fr, fq * 8);
#define PG8_SA(b, h) (((b) * 2 + (h)) * HTB)
#define PG8_SB(b, h) ((4 + (b) * 2 + (h)) * HTB)
#define PG8_STAGE(bufoff, gbase, voff) do { _Pragma("unroll") for (int _i = 0; _i < 2; ++_i) \
        __builtin_amdgcn_global_load_lds((const unsigned*)((const char*)(gbase) + (voff)[_i]), (LAS unsigned*)(lds + (bufoff) + ldsw + _i * 8192), 16, 0, 0); } while (0)
#define PG8_LDA(dst, b, h) do { _Pragma("unroll") for (int m = 0; m < 4; ++m) _Pragma("unroll") for (int k = 0; k < 2; ++k) dst[m][k] = *(const LAS bf16x8*)(lds + PG8_SA(b, h) + aoff + m * 2048 + k * 1024); } while (0)
#define PG8_LDB(dst, b, h) do { _Pragma("unroll") for (int n = 0; n < 2; ++n) _Pragma("unroll") for (int k = 0; k < 2; ++k) dst[n][k] = *(const LAS bf16x8*)(lds + PG8_SB(b, h) + boff + n * 2048 + k * 1024); } while (0)
#define PG8_MMA(ai, bj, At, Bt) do { __builtin_amdgcn_s_setprio(1); _Pragma("unroll") for (int m = 0; m < 4; ++m) _Pragma("unroll") for (int n = 0; n < 2; ++n) _Pragma("unroll") for (int k = 0; k < 2; ++k) \
        acc[ai][bj][m][n] = __builtin_amdgcn_mfma_f32_16x16x32_bf16(Bt[n][k], At[m][k], acc[ai][bj][m][n], 0, 0, 0); __builtin_amdgcn_s_setprio(0); } while (0)
#define PG8_WAIT_V(n) asm volatile("s_waitcnt vmcnt(" #n ")" ::: "memory")
#define PG8_WAIT_L(n) asm volatile("s_waitcnt lgkmcnt(" #n ")" ::: "memory")
#define PG8_BAR __builtin_amdgcn_s_barrier()
#define PG8_SCHED __builtin_amdgcn_sched_barrier(0)
    Unit cur, nxt; int ui = 0;
    if (!S.next(0, cur.pm, cur.pn)) return;
    P.locate(cur);
    int ntc = nt;
    if constexpr (Prob::VAR_NT) ntc = cur.nt;
    f32x4 acc[2][2][4][2];
#pragma unroll
    for (int a = 0; a < 2; ++a)
#pragma unroll
        for (int b = 0; b < 2; ++b)
#pragma unroll
            for (int m = 0; m < 4; ++m)
#pragma unroll
                for (int n = 0; n < 2; ++n) acc[a][b][m][n] = (f32x4){0.f, 0.f, 0.f, 0.f};
    bf16x8 At[4][2], B0[2][2], B1[2][2];
    const char* cA = cur.a; const char* cB = cur.b; int kstep = kfwd;
    if constexpr (SP2) {
        PG8_STAGE(PG8_SB(0, 0), cB, voffB); PG8_STAGE(PG8_SB(0, 1), cB + hstepB, voffB); PG8_STAGE(PG8_SA(0, 0), cA, voffA); PG8_STAGE(PG8_SA(0, 1), cA + hstepA, voffA);
        if (wr == 1) PG8_BAR;
        PG8_WAIT_V(2); PG8_BAR;
        PG8_STAGE(PG8_SB(1, 0), cB + kstep, voffB); PG8_STAGE(PG8_SA(1, 0), cA + kstep, voffA); PG8_STAGE(PG8_SB(1, 1), cB + hstepB + kstep, voffB);
        PG8_WAIT_V(6); PG8_BAR;
    } else {
        PG8_STAGE(PG8_SB(0, 0), cB, voffB); PG8_STAGE(PG8_SA(0, 0), cA, voffA); PG8_STAGE(PG8_SB(0, 1), cB + hstepB, voffB); PG8_STAGE(PG8_SA(0, 1), cA + hstepA, voffA);
        if (wr == 1) PG8_BAR;
        PG8_WAIT_V(4); PG8_BAR;
        PG8_STAGE(PG8_SB(1, 0), cB + kstep, voffB); PG8_STAGE(PG8_SA(1, 0), cA + kstep, voffA); PG8_STAGE(PG8_SB(1, 1), cB + hstepB + kstep, voffB);
        PG8_WAIT_V(6); PG8_BAR;
    }
    for (;;) {
        const bool has_next = S.next(ui + 1, nxt.pm, nxt.pn);
        if (has_next) P.locate(nxt);
        int ntn = ntc; if constexpr (Prob::VAR_NT) { if (has_next) ntn = nxt.nt; }
        const int nstep = KALT ? -kstep : kstep, noff = (KALT && nstep < 0) ? (ntn - 1) * kfwd : 0;
        const char* nA = has_next ? nxt.a + noff : cA; const char* nB = has_next ? nxt.b + noff : cB;
        const int nst = has_next ? nstep : kstep;
        for (int t = 0; t < ntc; t += 2) {
            const bool last = (t == ntc - 2);
            const char* a1 = cA + (t + 1) * kstep;
            const char* a2 = last ? nA : cA + (t + 2) * kstep; const char* b2 = last ? nB : cB + (t + 2) * kstep;
            const char* a3 = a2 + (last ? nst : kstep); const char* b3 = b2 + (last ? nst : kstep);
            if constexpr (SP2) {
            PG8_LDB(B0, 0, 0); PG8_LDB(B1, 0, 1); PG8_SCHED; PG8_LDA(At, 0, 0); PG8_STAGE(PG8_SA(1, 1), a1 + hstepA, voffA);
            PG8_WAIT_V(8); PG8_WAIT_L(0); PG8_BAR; PG8_MMA(0, 0, At, B0); PG8_MMA(0, 1, At, B1); PG8_BAR; PG8_SCHED;
            PG8_LDA(At, 0, 1); PG8_STAGE(PG8_SB(0, 0), b2, voffB); PG8_STAGE(PG8_SB(0, 1), b2 + hstepB, voffB); PG8_STAGE(PG8_SA(0, 0), a2, voffA);
            PG8_WAIT_V(8); PG8_WAIT_L(0); PG8_BAR; PG8_MMA(1, 0, At, B0); PG8_MMA(1, 1, At, B1); PG8_BAR; PG8_SCHED;
            PG8_LDB(B0, 1, 0); PG8_LDB(B1, 1, 1); PG8_SCHED; PG8_LDA(At, 1, 0); PG8_STAGE(PG8_SA(0, 1), a2 + hstepA, voffA);
            PG8_WAIT_V(8); PG8_WAIT_L(0); PG8_BAR; PG8_MMA(0, 0, At, B0); PG8_MMA(0, 1, At, B1); PG8_BAR; PG8_SCHED;
            PG8_LDA(At, 1, 1); PG8_STAGE(PG8_SB(1, 0), b3, voffB); PG8_STAGE(PG8_SB(1, 1), b3 + hstepB, voffB); PG8_STAGE(PG8_SA(1, 0), a3, voffA);
            PG8_WAIT_V(8); PG8_WAIT_L(0); PG8_BAR; PG8_MMA(1, 0, At, B0); PG8_MMA(1, 1, At, B1); PG8_BAR; PG8_SCHED;
            } else {
            PG8_LDB(B0, 0, 0); PG8_SCHED; PG8_LDA(At, 0, 0); PG8_STAGE(PG8_SA(1, 1), a1 + hstepA, voffA);
            PG8_WAIT_L(8); PG8_BAR; PG8_WAIT_L(0); PG8_MMA(0, 0, At, B0); PG8_BAR; PG8_SCHED;
            PG8_LDB(B1, 0, 1); PG8_STAGE(PG8_SB(0, 0), b2, voffB);
            PG8_BAR; PG8_WAIT_L(0); PG8_MMA(0, 1, At, B1); PG8_BAR;
            PG8_LDA(At, 0, 1); PG8_STAGE(PG8_SA(0, 0), a2, voffA);
            PG8_BAR; PG8_WAIT_L(0); PG8_MMA(1, 0, At, B0); PG8_BAR; PG8_SCHED;
            PG8_STAGE(PG8_SB(0, 1), b2 + hstepB, voffB);
            PG8_WAIT_V(6); PG8_BAR; PG8_MMA(1, 1, At, B1); PG8_BAR;
            PG8_LDB(B0, 1, 0); PG8_SCHED; PG8_LDA(At, 1, 0); PG8_STAGE(PG8_SA(0, 1), a2 + hstepA, voffA);
            PG8_WAIT_L(8); PG8_BAR; PG8_WAIT_L(0); PG8_MMA(0, 0, At, B0); PG8_BAR; PG8_SCHED;
            PG8_LDB(B1, 1, 1); PG8_STAGE(PG8_SB(1, 0), b3, voffB);
            PG8_BAR; PG8_WAIT_L(0); PG8_MMA(0, 1, At, B1); PG8_BAR;
            PG8_LDA(At, 1, 1); PG8_STAGE(PG8_SA(1, 0), a3, voffA);
            PG8_BAR; PG8_WAIT_L(0); PG8_MMA(1, 0, At, B0); PG8_BAR; PG8_SCHED;
            PG8_STAGE(PG8_SB(1, 1), b3 + hstepB, voffB);
            PG8_WAIT_V(6); PG8_BAR; PG8_MMA(1, 1, At, B1); PG8_BAR;
            }
        }
        if constexpr (ALIGN_EPI) { if (wr == 0) PG8_BAR; }
        E(acc, cur, wr, wc, fr, fq);
        if (!has_next) break;
#pragma unroll
        for (int a = 0; a < 2; ++a)
#pragma unroll
            for (int b = 0; b < 2; ++b)
#pragma unroll
                for (int m = 0; m < 4; ++m)
#pragma unroll
                    for (int n = 0; n < 2; ++n) acc[a][b][m][n] = (f32x4){0.f, 0.f, 0.f, 0.f};
        cur = nxt; cA = nA; cB = nB; kstep = nst; ntc = ntn; ++ui;
        if constexpr (ALIGN_EPI) { if (wr == 1) PG8_BAR; }
    }
    PG8_WAIT_V(0);
    if constexpr (!ALIGN_EPI) { if (wr == 0) PG8_BAR; }
    PG8_BAR;
#undef PG8_SA
#undef PG8_SB
#undef PG8_STAGE
#undef PG8_LDA
#undef PG8_LDB
#undef PG8_MMA
#undef PG8_WAIT_V
#undef PG8_WAIT_L
#undef PG8_BAR
#undef PG8_SCHED
}
}

struct ProbSimple {
    static constexpr bool VAR_NT = false;
    const bf16_t* A; const bf16_t* Bt; int lda, ldb, K, nM, nN;
    __device__ __forceinline__ void locate(pg8::Unit& u) const { u.sub = 0; u.pnl = u.pn;
        u.a = (const char*)A + (size_t)u.pm * 256 * lda * 2; u.b = (const char*)Bt + (size_t)u.pn * 256 * ldb * 2; }
};
struct ProbPool {
    static constexpr bool VAR_NT = false;
    const bf16_t* A; const bf16_t* Bt; int lda, ldb, K, nM, nN;
    __device__ __forceinline__ void locate(pg8::Unit& u) const { u.sub = 0; u.pnl = u.pn;
        u.a = (const char*)A + ((size_t)u.pm * 256 * lda + (size_t)(u.pn >> 1) * 512) * 2; u.b = (const char*)Bt + (size_t)u.pn * 256 * ldb * 2; }
};
struct ProbRwkv1 {
    static constexpr bool VAR_NT = false;
    const bf16_t* X6; const bf16_t* Wrkv; const bf16_t* Wl1; int lda, ldb, K, nM, nN;
    __device__ __forceinline__ void locate(pg8::Unit& u) const {
        int xi; const char* b;
        if (u.pn < 24) { u.sub = u.pn >> 3; u.pnl = u.pn & 7; xi = u.sub == 0 ? 0 : (u.sub == 1 ? 2 : 3); b = (const char*)Wrkv + (size_t)u.sub * SZ_SQ + (size_t)u.pnl * 256 * ldb * 2; }
        else { const int j = u.pn - 24; u.sub = 3 + j; u.pnl = 0; xi = j == 0 ? 1 : (j == 1 ? 4 : 5); b = (const char*)Wl1 + (size_t)j * 256 * ldb * 2; }
        u.a = (const char*)X6 + (size_t)xi * SZ_H + (size_t)u.pm * 256 * lda * 2; u.b = b; }
};
struct ProbRwkv2 {
    static constexpr bool VAR_NT = true;
    const bf16_t* L1; const bf16_t* Ww2; const bf16_t* Wa2; const bf16_t* Wg2; int lda, ldb, K, nM, nN;
    __device__ __forceinline__ void locate(pg8::Unit& u) const {
        const bf16_t* w;
        if (u.pn < 16) { u.sub = 0; u.pnl = u.pn; w = Ww2; } else if (u.pn < 32) { u.sub = 1; u.pnl = u.pn - 16; w = Wa2; } else { u.sub = 2; u.pnl = u.pn - 32; w = Wg2; }
        const int e = u.sub < 2 ? (u.pnl >> 3) : 0; u.nt = u.sub < 2 ? 2 : 4;
        u.a = (const char*)L1 + ((size_t)u.pm * 256 * lda + (size_t)u.sub * 256 + (size_t)e * 128) * 2; u.b = (const char*)w + (size_t)u.pnl * 256 * ldb * 2; }
};

#define EPI_ARGS const f32x4 (&acc)[2][2][4][2], const pg8::Unit& u, int wr, int wc, int fr, int fq
struct EpiResid {
    float* xf; bf16_t* xb; const float* gate; const float* cscale; float* rowsq; const float* xs_lo; const float* xs_hi; int mode;
    template <int MODE> __device__ __forceinline__ void run(EPI_ARGS) const {
        const int cond = u.pm < 16 ? 0 : 1 + ((u.pm - 16) >> 3);
        const int col0 = u.pn * 256 + wc * 32 + 4 * fq;
        const float* gp = gate + (size_t)cond * MODW + col0;
        f32x4 gv[2][2];
#pragma unroll
        for (int bj = 0; bj < 2; ++bj)
#pragma unroll
            for (int n = 0; n < 2; ++n) { gv[bj][n] = *(const f32x4*)(gp + bj * 128 + n * 16); if (cscale) gv[bj][n] *= *(const f32x4*)(cscale + col0 + bj * 128 + n * 16); }
#pragma unroll
        for (int ai = 0; ai < 2; ++ai) {
            f32x4 xo4[MODE == 0 ? 4 : 1][2][2]; u32x2 xo2[MODE == 0 ? 1 : 4][2][2];
#pragma unroll
            for (int m = 0; m < 4; ++m) {
                const int row = u.pm * 256 + ai * 128 + wr * 64 + m * 16 + fr;
#pragma unroll
                for (int bj = 0; bj < 2; ++bj)
#pragma unroll
                    for (int n = 0; n < 2; ++n) {
                        if constexpr (MODE == 0) xo4[m][bj][n] = *(const f32x4*)((u.pm < 16 ? xs_lo + (size_t)row * DM : xs_hi + (size_t)(row - M_P) * DM) + col0 + bj * 128 + n * 16);
                        else xo2[m][bj][n] = *(const u32x2*)(xb + (size_t)row * PK + col0 + bj * 128 + n * 16); } }
            __builtin_amdgcn_sched_barrier(0);
#pragma unroll
            for (int m = 0; m < 4; ++m) {
                const int row = u.pm * 256 + ai * 128 + wr * 64 + m * 16 + fr; float ss = 0.f;
                bf16_t* xbr = xb + (size_t)row * PK + col0;
#pragma unroll
                for (int bj = 0; bj < 2; ++bj)
#pragma unroll
                    for (int n = 0; n < 2; ++n) { f32x4 xv;
                        if constexpr (MODE == 0) xv = xo4[m][bj][n]; else xv = bf4_to_f32(xo2[m][bj][n]);
                        xv += gv[bj][n] * acc[ai][bj][m][n];
                        if constexpr (MODE == 2) *(f32x4*)(xf + (size_t)row * DM + col0 + bj * 128 + n * 16) = xv;
                        else { const u32x2 w = f32_to_bf4(xv); *(u32x2*)(xbr + bj * 128 + n * 16) = w; xv = bf4_to_f32(w); }
                        ss += (xv.x * xv.x + xv.y * xv.y) + (xv.z * xv.z + xv.w * xv.w); }
                ss += __shfl_xor(ss, 16); ss += __shfl_xor(ss, 32);
                if (fq == 0) rowsq[(size_t)(u.pn * 4 + wc) * M + row] = ss;
            }
        }
    }
    __device__ __forceinline__ void operator()(EPI_ARGS) const {
        if (mode == 0) run<0>(acc, u, wr, wc, fr, fq); else if (mode == 1) run<1>(acc, u, wr, wc, fr, fq); else run<2>(acc, u, wr, wc, fr, fq);
    }
};
struct EpiBf16 {
    bf16_t* out; int ldc;
    __device__ __forceinline__ void operator()(EPI_ARGS) const {
        const int col0 = u.pn * 256 + wc * 32 + 4 * fq;
#pragma unroll
        for (int ai = 0; ai < 2; ++ai)
#pragma unroll
            for (int m = 0; m < 4; ++m) {
                const int row = u.pm * 256 + ai * 128 + wr * 64 + m * 16 + fr; bf16_t* op = out + (size_t)row * ldc + col0;
#pragma unroll
                for (int bj = 0; bj < 2; ++bj)
#pragma unroll
                    for (int n = 0; n < 2; ++n) *(u32x2*)(op + bj * 128 + n * 16) = f32_to_bf4(acc[ai][bj][m][n]);
            }
    }
};

__device__ __forceinline__ float dpp_ror1(float x)  { return __builtin_bit_cast(float, __builtin_amdgcn_update_dpp(0, __builtin_bit_cast(int, x), 0x121, 0xF, 0xF, true)); }
__device__ __forceinline__ float dpp_ror15(float x) { return __builtin_bit_cast(float, __builtin_amdgcn_update_dpp(0, __builtin_bit_cast(int, x), 0x12F, 0xF, 0xF, true)); }
__device__ __forceinline__ float dpp_shr1_old(float old, float x) { return __builtin_bit_cast(float, __builtin_amdgcn_update_dpp(__builtin_bit_cast(int, old), __builtin_bit_cast(int, x), 0x111, 0xF, 0xF, false)); }
__device__ __forceinline__ float dpp_shl1_old(float old, float x) { return __builtin_bit_cast(float, __builtin_amdgcn_update_dpp(__builtin_bit_cast(int, old), __builtin_bit_cast(int, x), 0x101, 0xF, 0xF, false)); }
struct EpiUpConv {
    bf16_t* act; float* halo; const float* cw; const float* cb; LAS float* xch;
    __device__ __forceinline__ void operator()(EPI_ARGS) const {
        const int cl = 32 * wc + 4 * fq;
#pragma unroll
        for (int ai = 0; ai < 2; ++ai) { const int seg = 2 * ai + wr;
            if (fr == 0) {
#pragma unroll
                for (int bj = 0; bj < 2; ++bj)
#pragma unroll
                    for (int n = 0; n < 2; ++n) *(LAS f32x4*)(xch + ((((seg * 4 + wc) * 2 + 0) * 2 + bj) * 2 + n) * 16 + 4 * fq) = acc[ai][bj][0][n]; }
            if (fr == 15) {
#pragma unroll
                for (int bj = 0; bj < 2; ++bj)
#pragma unroll
                    for (int n = 0; n < 2; ++n) *(LAS f32x4*)(xch + ((((seg * 4 + wc) * 2 + 1) * 2 + bj) * 2 + n) * 16 + 4 * fq) = acc[ai][bj][3][n]; } }
        if (wr == 0 && fr < 2) {
#pragma unroll
            for (int bj = 0; bj < 2; ++bj)
#pragma unroll
                for (int n = 0; n < 2; ++n) *(f32x4*)(halo + ((size_t)u.pm * 4 + fr) * FF2 + u.pn * 256 + bj * 128 + cl + 16 * n) = acc[0][bj][0][n]; }
        if (wr == 1 && fr >= 14) {
#pragma unroll
            for (int bj = 0; bj < 2; ++bj)
#pragma unroll
                for (int n = 0; n < 2; ++n) *(f32x4*)(halo + ((size_t)u.pm * 4 + 2 + (fr - 14)) * FF2 + u.pn * 256 + bj * 128 + cl + 16 * n) = acc[1][bj][3][n]; }
        asm volatile("s_waitcnt lgkmcnt(0)" ::: "memory"); __builtin_amdgcn_s_barrier(); asm volatile("" ::: "memory");
#pragma unroll
        for (int n = 0; n < 2; ++n) {
            const int ch = u.pn * 128 + cl + 16 * n;
            f32x4 wg[3], wv[3];
#pragma unroll
            for (int j = 0; j < 3; ++j) { wg[j] = *(const f32x4*)(cw + (size_t)j * FF2 + ch); wv[j] = *(const f32x4*)(cw + (size_t)j * FF2 + FF + ch); }
            const f32x4 bg = *(const f32x4*)(cb + ch), bv = *(const f32x4*)(cb + FF + ch);
#pragma unroll
            for (int ai = 0; ai < 2; ++ai) { const int seg = 2 * ai + wr;
                f32x4 xp[2], xn[2];
#pragma unroll
                for (int bj = 0; bj < 2; ++bj) {
                    xp[bj] = seg > 0 ? *(const LAS f32x4*)(xch + (((((seg - 1) * 4 + wc) * 2 + 1) * 2 + bj) * 2 + n) * 16 + 4 * fq) : (f32x4){0.f, 0.f, 0.f, 0.f};
                    xn[bj] = seg < 3 ? *(const LAS f32x4*)(xch + (((((seg + 1) * 4 + wc) * 2 + 0) * 2 + bj) * 2 + n) * 16 + 4 * fq) : (f32x4){0.f, 0.f, 0.f, 0.f}; }
#pragma unroll
                for (int m = 0; m < 4; ++m) {
                    f32x4 uc[2];
#pragma unroll
                    for (int bj = 0; bj < 2; ++bj) {
                        const f32x4 cur = acc[ai][bj][m][n]; f32x4 pv, nx;
#pragma unroll
                        for (int e = 0; e < 4; ++e) {
                            const float oldp = m == 0 ? xp[bj][e] : dpp_ror1(acc[ai][bj][m == 0 ? 0 : m - 1][n][e]);
                            const float oldn = m == 3 ? xn[bj][e] : dpp_ror15(acc[ai][bj][m == 3 ? 3 : m + 1][n][e]);
                            pv[e] = dpp_shr1_old(oldp, cur[e]); nx[e] = dpp_shl1_old(oldn, cur[e]); }
                        const f32x4 w0 = bj == 0 ? wg[0] : wv[0], w1 = bj == 0 ? wg[1] : wv[1], w2 = bj == 0 ? wg[2] : wv[2], bb = bj == 0 ? bg : bv;
                        uc[bj] = w0 * pv + w1 * cur + w2 * nx + bb; }
                    f32x4 o;
#pragma unroll
                    for (int e = 0; e < 4; ++e) o[e] = siluf_(uc[0][e]) * uc[1][e];
                    const int row = u.pm * 256 + ai * 128 + wr * 64 + m * 16 + fr;
                    *(u32x2*)(act + (size_t)row * PF + ch) = f32_to_bf4(o); } }
        }
    }
};
struct EpiRwkv1 {
    bf16_t* rkv; bf16_t* l1;
    __device__ __forceinline__ void operator()(EPI_ARGS) const {
        const int cl = wc * 32 + 4 * fq; const int sub = u.sub;
        bf16_t* base; int ldc;
        if (sub < 3) { base = rkv + (size_t)sub * M * PK + u.pnl * 256 + cl; ldc = PK; } else { base = l1 + (sub - 3) * 256 + cl; ldc = PL1; }
#pragma unroll
        for (int ai = 0; ai < 2; ++ai)
#pragma unroll
            for (int m = 0; m < 4; ++m) {
                const int row = u.pm * 256 + ai * 128 + wr * 64 + m * 16 + fr; bf16_t* op = base + (size_t)row * ldc;
#pragma unroll
                for (int bj = 0; bj < 2; ++bj)
#pragma unroll
                    for (int n = 0; n < 2; ++n) { f32x4 v = acc[ai][bj][m][n];
                        if (sub == 3) { v.x = tanhf_(v.x); v.y = tanhf_(v.y); v.z = tanhf_(v.z); v.w = tanhf_(v.w); }
                        else if (sub == 5) { v.x = sigmoidf_(v.x); v.y = sigmoidf_(v.y); v.z = sigmoidf_(v.z); v.w = sigmoidf_(v.w); }
                        *(u32x2*)(op + bj * 128 + n * 16) = f32_to_bf4(v); }
            }
    }
};
struct EpiRwkv2 {
    float* dec; bf16_t* aa; bf16_t* g; const float* w0; const float* a0;
    __device__ __forceinline__ void operator()(EPI_ARGS) const {
        const int sub = u.sub; const int e = (sub < 2) ? (u.pnl >> 3) : 0; const int col0 = ((sub < 2) ? (u.pnl & 7) : u.pnl) * 256 + wc * 32 + 4 * fq;
        f32x4 bv[2][2];
#pragma unroll
        for (int bj = 0; bj < 2; ++bj)
#pragma unroll
            for (int n = 0; n < 2; ++n) bv[bj][n] = sub == 0 ? *(const f32x4*)(w0 + e * DM + col0 + bj * 128 + n * 16) : (sub == 1 ? *(const f32x4*)(a0 + e * DM + col0 + bj * 128 + n * 16) : (f32x4){0.f, 0.f, 0.f, 0.f});
#pragma unroll
        for (int ai = 0; ai < 2; ++ai)
#pragma unroll
            for (int m = 0; m < 4; ++m) {
                const int row = u.pm * 256 + ai * 128 + wr * 64 + m * 16 + fr; const size_t off = ((size_t)e * M + row) * PK + col0;
#pragma unroll
                for (int bj = 0; bj < 2; ++bj)
#pragma unroll
                    for (int n = 0; n < 2; ++n) { f32x4 v = acc[ai][bj][m][n] + bv[bj][n];
                        if (sub == 0) { v.x = __expf(-0.606531f * sigmoidf_(v.x)); v.y = __expf(-0.606531f * sigmoidf_(v.y)); v.z = __expf(-0.606531f * sigmoidf_(v.z)); v.w = __expf(-0.606531f * sigmoidf_(v.w));
                            *(f32x4*)(dec + off + bj * 128 + n * 16) = v; }
                        else if (sub == 1) { v.x = sigmoidf_(v.x); v.y = sigmoidf_(v.y); v.z = sigmoidf_(v.z); v.w = sigmoidf_(v.w); *(u32x2*)(aa + off + bj * 128 + n * 16) = f32_to_bf4(v); }
                        else *(u32x2*)(g + off + bj * 128 + n * 16) = f32_to_bf4(v); }
            }
    }
};

struct Args { const float* in[N_IN]; float* out; unsigned char* ws; int ph_lo, ph_hi; };

__device__ __forceinline__ void transpose_item(const float* src, int ld_src, int Kvalid, int k0, int n0, bf16_t* dst, int ld_dst, int drow0, int dcol0, LAS float* scr, int lane) {
#pragma unroll 8
    for (int i = 0; i < 32; ++i) { const int kk = 2 * i + (lane >> 5); scr[kk * 33 + (lane & 31)] = (k0 + kk < Kvalid) ? src[(size_t)(k0 + kk) * ld_src + n0 + (lane & 31)] : 0.f; }
    asm volatile("s_waitcnt lgkmcnt(0)" ::: "memory");
    const int c = lane & 7;
#pragma unroll
    for (int j = 0; j < 4; ++j) { const int n = (lane >> 3) + 8 * j; const LAS float* s = scr + (8 * c) * 33 + n;
        u32x4 o; o.x = pk2(s[0 * 33], s[1 * 33]); o.y = pk2(s[2 * 33], s[3 * 33]); o.z = pk2(s[4 * 33], s[5 * 33]); o.w = pk2(s[6 * 33], s[7 * 33]);
        if (k0 + 8 * c < Kvalid) *(u32x4*)(dst + (size_t)(drow0 + n) * ld_dst + dcol0 + k0 + 8 * c) = o; }
    asm volatile("s_waitcnt lgkmcnt(0)" ::: "memory");
}

__device__ __forceinline__ void transpose_item64(const float* src, int ld_src, int Kvalid, int k0, int n0, bf16_t* dst, int ld_dst, int drow0, int dcol0, LAS unsigned* scr, int lane) {
    const int n4 = lane & 15, kr = lane >> 4;
    const f32x4 z = {0.f, 0.f, 0.f, 0.f};
#pragma unroll
    for (int it = 0; it < 8; ++it) { const int k = k0 + 8 * it + 2 * kr; const float* p = src + (size_t)k * ld_src + n0 + 4 * n4;
        const f32x4 a = (k < Kvalid) ? *(const f32x4*)p : z, b = (k + 1 < Kvalid) ? *(const f32x4*)(p + ld_src) : z;
#pragma unroll
        for (int j = 0; j < 4; ++j) scr[(4 * n4 + j) * 33 + 4 * it + kr] = pk2(a[j], b[j]); }
    asm volatile("s_waitcnt lgkmcnt(0)" ::: "memory");
    const int c = lane & 7;
#pragma unroll
    for (int jj = 0; jj < 8; ++jj) { const int n = (lane >> 3) + 8 * jj; const LAS unsigned* s = scr + n * 33 + 4 * c;
        u32x4 o; o.x = s[0]; o.y = s[1]; o.z = s[2]; o.w = s[3];
        if (k0 + 8 * c < Kvalid) *(u32x4*)(dst + (size_t)(drow0 + n) * ld_dst + dcol0 + k0 + 8 * c) = o; }
    asm volatile("s_waitcnt lgkmcnt(0)" ::: "memory");
}

__device__ __forceinline__ void convert_weights(const Args& A, LAS unsigned char* lds, int set, int part, int gw, int NGW) {
    const int tid = opaque_tid(), lane = tid & 63, wave = tid >> 6;
    unsigned char* ws = A.ws;
    LAS float* scr = (LAS float*)(lds + wave * 16384);
    LAS unsigned* scu = (LAS unsigned*)(lds + wave * 16384);
    constexpr int NI_UPL = 32 * 176, NI_DNL = 88 * 32, NI_PL = 8 * 8, NI_SQ = 32 * 32, NI_L1 = 32 * 3, NI_G1 = 32 * 4, NI_L2 = 2 * 32, NI_G2 = 4 * 32, NI_Q = 32 * 48;
    const int l = set;
    const int nextra = (set == 0 || set == 3) ? 4 * NI_PL : (set == 1 ? 4 * NI_SQ + 4 * NI_L1 + NI_G1 + 4 * NI_L2 + NI_G2 : NI_Q + NI_SQ);
    const int lo = part == 2 ? NI_UPL + NI_DNL : 0, nitems = part == 1 ? NI_UPL + NI_DNL : NI_UPL + NI_DNL + nextra;
    for (int it = lo + gw; it < nitems; it += NGW) {
        int r = it;
        if (r < NI_UPL) { const int kb = r / 176, nb = r % 176, n0 = nb * 64;
            const int drow0 = n0 < FF ? (n0 >> 7) * 256 + (n0 & 127) : ((n0 - FF) >> 7) * 256 + 128 + ((n0 - FF) & 127);
            transpose_item64(A.in[I_UP] + (size_t)l * DM * FF2, FF2, DM, kb * 64, n0, (bf16_t*)(ws + WS_WUP + l * SZ_UP), PK, drow0, 0, scu, lane); continue; }
        r -= NI_UPL;
        if (r < NI_DNL) { const int kb = r / 32, nb = r % 32;
            transpose_item64(A.in[I_DOWN] + (size_t)l * FF * DM, DM, FF, kb * 64, nb * 64, (bf16_t*)(ws + WS_WDN + l * SZ_DN), PF, nb * 64, 0, scu, lane); continue; }
        r -= NI_DNL;
        if (set == 0 || set == 3) { const int sg = (set == 0 ? 0 : 4) + r / NI_PL; r %= NI_PL; const int kb = r / 8, nb = r % 8;
            transpose_item64(A.in[I_POOLW] + (size_t)sg * 512 * 512, 512, 512, kb * 64, nb * 64, (bf16_t*)(ws + WS_WPOOL) + (size_t)sg * 512 * PPW, PPW, nb * 64, 0, scu, lane); continue; }
        if (set == 1) {
            if (r < 4 * NI_SQ) { const int w = r / NI_SQ; r %= NI_SQ; const int kb = r / 32, nb = r % 32; const int idx = w == 0 ? I_WR : (w == 1 ? I_WK : (w == 2 ? I_WV : I_WO));
                transpose_item64(A.in[idx], DM, DM, kb * 64, nb * 64, (bf16_t*)(ws + WS_WR + w * SZ_SQ), PK, nb * 64, 0, scu, lane); continue; }
            r -= 4 * NI_SQ;
            if (r < 4 * NI_L1) { const int we = r / NI_L1; r %= NI_L1; const int which = we >> 1, e = we & 1, kb = r / 3, nb = r % 3;
                transpose_item(A.in[which ? I_A1 : I_W1] + (size_t)e * DM * 96, 96, DM, kb * 64, nb * 32, (bf16_t*)(ws + WS_WL1), PK, which * 256 + e * 128 + nb * 32, 0, scr, lane); continue; }
            r -= 4 * NI_L1;
            if (r < NI_G1) { const int kb = r / 4, nb = r % 4;
                transpose_item64(A.in[I_G1], 256, DM, kb * 64, nb * 64, (bf16_t*)(ws + WS_WL1), PK, 512 + nb * 64, 0, scu, lane); continue; }
            r -= NI_G1;
            if (r < 4 * NI_L2) { const int we = r / NI_L2; r %= NI_L2; const int which = we >> 1, e = we & 1, kb = r / 32, nb = r % 32;
                transpose_item64(A.in[which ? I_A2 : I_W2] + (size_t)e * 96 * DM, DM, 96, kb * 64, nb * 64, (bf16_t*)(ws + (which ? WS_WA2 : WS_WW2)), PW2, e * DM + nb * 64, 0, scu, lane); continue; }
            r -= 4 * NI_L2;
            { const int kb = r / 32, nb = r % 32;
                transpose_item64(A.in[I_G2], DM, 256, kb * 64, nb * 64, (bf16_t*)(ws + WS_WG2), PW2, nb * 64, 0, scu, lane); continue; }
        }
        if (r < NI_Q) { const int kb = r / 48, nb = r % 48;
            transpose_item64(A.in[I_QKV], 3072, DM, kb * 64, nb * 64, (bf16_t*)(ws + WS_WQKV), PK, nb * 64, 0, scu, lane); continue; }
        r -= NI_Q;
        { const int kb = r / 32, nb = r % 32;
            transpose_item64(A.in[I_AO], DM, DM, kb * 64, nb * 64, (bf16_t*)(ws + WS_WAO), PK, nb * 64, 0, scu, lane); }
    }
}

__device__ __forceinline__ void phase_prologue(const Args& A, LAS unsigned char* lds) {
    const int tid = opaque_tid(), lane = tid & 63, wave = tid >> 6, G = gridDim.x, bx = blockIdx.x;
    unsigned char* ws = A.ws;
    for (int rep_ = 0; rep_ < REP_ADA; ++rep_) {
        LAS float* sl = (LAS float*)lds;
        LAS float* red = (LAS float*)(lds + 73728);
        const float* cc = A.in[I_C]; const float* cctx = A.in[I_CCTX];
        for (int i = tid; i < NCOND * DM; i += NTHREADS) { const int r = i / DM, k = i % DM; const float c = r == 0 ? cctx[k] : cc[(r - 1) * DM + k]; sl[k * 9 + r] = siluf_(c); }
        __syncthreads();
        float* mod = (float*)(ws + WS_MOD);
        for (int item = bx; item < 4 * 192; item += G) {
            const int l = item / 192, n0 = (item % 192) * 64;
            const float* W = A.in[I_ADAW] + (size_t)l * DM * MODW + n0 + (lane & 15) * 4;
            const int kr = tid >> 4;
            f32x4 acc[9];
#pragma unroll
            for (int r = 0; r < 9; ++r) acc[r] = (f32x4){0.f, 0.f, 0.f, 0.f};
#pragma unroll 8
            for (int k = kr; k < DM; k += 32) { const f32x4 w = *(const f32x4*)(W + (size_t)k * MODW);
#pragma unroll
                for (int r = 0; r < 9; ++r) acc[r] += sl[k * 9 + r] * w; }
#pragma unroll
            for (int r = 0; r < 9; ++r)
#pragma unroll
                for (int j = 0; j < 4; ++j) { float v = acc[r][j]; v += __shfl_xor(v, 16); v += __shfl_xor(v, 32); acc[r][j] = v; }
            if (lane < 16) {
#pragma unroll
                for (int r = 0; r < 9; ++r) *(LAS f32x4*)(red + (wave * 9 + r) * 64 + lane * 4) = acc[r];
            }
            __syncthreads();
            for (int o = tid; o < 9 * 64; o += NTHREADS) { const int r = o >> 6, c = o & 63; float s = 0.f;
#pragma unroll
                for (int w = 0; w < 8; ++w) s += red[(w * 9 + r) * 64 + c];
                mod[((size_t)l * 9 + r) * MODW + n0 + c] = s + A.in[I_ADAB][l * MODW + n0 + c]; }
            __syncthreads();
        }
    }
    __syncthreads();
    for (int rep_ = 0; rep_ < REP_TR; ++rep_) {
        const int gw = bx * NWAVES + wave, NGW = G * NWAVES;
        convert_weights(A, lds, 0, 0, gw, NGW);
        convert_weights(A, lds, 1, 2, gw, NGW);
        float* rowsq0 = (float*)(ws + WS_RSQ);
        for (int m = gw; m < M; m += NGW) {
            const float* src = m < M_P ? A.in[I_XP] + (size_t)m * DM : A.in[I_XS] + (size_t)(m - M_P) * DM; float ss = 0.f;
#pragma unroll
            for (int j = 0; j < 8; ++j) { const f32x4 v = *(const f32x4*)(src + 4 * lane + 256 * j); ss += (v.x * v.x + v.y * v.y) + (v.z * v.z + v.w * v.w); }
            ss = wave_sum(ss);
            if (lane == 0) rowsq0[m] = ss;
        }
    }
    {
        const int gt = bx * NTHREADS + tid, NT = G * NTHREADS; const u32x4 z4 = {0u, 0u, 0u, 0u};
        constexpr int PCS = PK * 2 / 16;
        for (int i = gt; i < 4 * 32 * PCS; i += NT) { const int blk = i / (32 * PCS), r = (i / PCS) % 32, pc = i % PCS;
            *(u32x4*)(ws + WS_WL1 + (size_t)(blk * 128 + 96 + r) * PK * 2 + pc * 16) = z4; }
        for (int i = gt; i < 2 * 4096 * 4; i += NT) { const int row = i >> 2, pc = i & 3;
            *(u32x4*)(ws + WS_WW2 + ((size_t)row * PW2 + 96) * 2 + pc * 16) = z4; }
    }
    {
        constexpr int NV = 8 * 512 * 512 / 8;
        for (int i = bx * NTHREADS + tid; i < 2 * NV; i += G * NTHREADS) {
            const bool isv = i >= NV; const int j = isv ? i - NV : i;
            const float* s = A.in[isv ? I_CV : I_CK] + (size_t)j * 8; const f32x4 a = *(const f32x4*)s, b = *(const f32x4*)(s + 4);
            u32x4 o; o.x = pk2(a.x, a.y); o.y = pk2(a.z, a.w); o.z = pk2(b.x, b.y); o.w = pk2(b.z, b.w);
            *(u32x4*)((bf16_t*)(ws + (isv ? WS_CVB : WS_CKB)) + (size_t)j * 8) = o;
        }
    }
}

__device__ __forceinline__ void phase_normmod(const bf16_t* xb, RowSq rowsq, const float* gain, const float* mod_sh, const float* mod_sc, bf16_t* out) {
    const int tid_ = opaque_tid(), lane = tid_ & 63, gw = blockIdx.x * NWAVES + (tid_ >> 6), NGW = gridDim.x * NWAVES;
    const int rpw = ((M + NGW - 1) / NGW + 1) & ~1;
    const int m_lo = gw * rpw, m_hi = min(M, m_lo + rpw);
    int ccur = -1; f32x4 G[4][2], S1[4][2], S0[4][2];
    for (int m = m_lo; m < m_hi; m += 2) {
        const float p0 = lane < rowsq.n ? rowsq.p[(size_t)lane * M + m] : 0.f, p1 = lane < rowsq.n ? rowsq.p[(size_t)lane * M + m + 1] : 0.f;
        u32x4 xa[4], xc[4];
#pragma unroll
        for (int j = 0; j < 4; ++j) { xa[j] = *(const u32x4*)(xb + (size_t)m * PK + 8 * lane + 512 * j); xc[j] = *(const u32x4*)(xb + (size_t)(m + 1) * PK + 8 * lane + 512 * j); }
#pragma unroll
        for (int h = 0; h < 2; ++h) {
            const int mm = m + h, cond = cond_of_row(mm);
            if (cond != ccur) { ccur = cond;
#pragma unroll
                for (int j = 0; j < 4; ++j)
#pragma unroll
                    for (int u = 0; u < 2; ++u) { const int c = 8 * lane + 512 * j + 4 * u; G[j][u] = *(const f32x4*)(gain + c); S1[j][u] = 1.f + *(const f32x4*)(mod_sc + (size_t)cond * MODW + c); S0[j][u] = *(const f32x4*)(mod_sh + (size_t)cond * MODW + c); } }
            const float rstd = rsqrtf(wave_sum(h == 0 ? p0 : p1) * (1.f / DM) + NORM_EPS);
            bf16_t* o = out + (size_t)mm * PK;
#pragma unroll
            for (int j = 0; j < 4; ++j) { const u32x4 w = h == 0 ? xa[j] : xc[j];
                const f32x4 lo = bf4_to_f32((u32x2){w.x, w.y}), hi = bf4_to_f32((u32x2){w.z, w.w});
                const u32x2 a = f32_to_bf4((lo * rstd * G[j][0]) * S1[j][0] + S0[j][0]), b = f32_to_bf4((hi * rstd * G[j][1]) * S1[j][1] + S0[j][1]);
                *(u32x4*)(o + 8 * lane + 512 * j) = (u32x4){a.x, a.y, b.x, b.y}; }
        }
    }
}
__device__ __forceinline__ void rows_rstd(RowSq rowsq, int sb, int T, int tfirst, int NR, LAS float* rs, int tid) {
    const int i = tid >> 3, j = tid & 7, t = tfirst + i;
    const int tc = min(max(t, 0), T - 1), m = sb + tc;
    float s = 0.f;
#pragma unroll
    for (int q = 0; q < RSQ_PARTS / 8; ++q) { const int idx = j + 8 * q; s += idx < rowsq.n ? rowsq.p[(size_t)idx * M + m] : 0.f; }
    s = DPP_ADD(s, 0xB1); s = DPP_ADD(s, 0x4E); s = DPP_ADD(s, 0x141);
    if (j == 0 && i < NR) rs[i] = rsqrtf(s * (1.f / DM) + NORM_EPS);
}

template <int GI>
__device__ __forceinline__ void pool_item(const float* x_lo, const float* x_hi, const bf16_t* xb, RowSq rowsq, const float* gain, const float* mod_sh, const float* mod_sc, bf16_t* out, LAS float* tile, LAS float* rs, int chunk, int c) {
    constexpr int WIN = 2 << GI, LEFT = WIN >> 1, RIGHT = WIN - 1 - LEFT, R0 = 8 - LEFT, NRW = 32 + LEFT + RIGHT;
    const int m0 = chunk * 32;
    int sb, T; if (m0 < M_P) { sb = m0 & ~(T_P - 1); T = T_P; } else { sb = M_P + ((m0 - M_P) & ~(T_S - 1)); T = T_S; }
    const int t0 = m0 - sb, cond = cond_of_row(m0), col = GI * 512 + c;
    rows_rstd(rowsq, sb, T, t0 - 8, 48, rs, c);
    constexpr int NJ = (NRW + 3) / 4;
    const int c4 = (c & 127) * 4, rsub = c >> 7, col4 = GI * 512 + c4;
    const f32x4 g4 = *(const f32x4*)(gain + col4), s14 = 1.f + *(const f32x4*)(mod_sc + (size_t)cond * MODW + col4), s04 = *(const f32x4*)(mod_sh + (size_t)cond * MODW + col4);
    f32x4 xv[NJ];
#pragma unroll
    for (int j = 0; j < NJ; ++j) { const int i = rsub + 4 * j, t = t0 - LEFT + i, tc = min(max(t, 0), T - 1), m = sb + tc;
        xv[j] = xb ? bf4_to_f32(*(const u32x2*)(xb + (size_t)m * PK + col4)) : *(const f32x4*)(m < M_P ? x_lo + (size_t)m * DM + col4 : x_hi + (size_t)(m - M_P) * DM + col4); }
    __syncthreads();
    const f32x4 zero4 = {0.f, 0.f, 0.f, 0.f};
#pragma unroll
    for (int j = 0; j < NJ; ++j) { const int i = rsub + 4 * j, t = t0 - LEFT + i;
        if (i < NRW) *(LAS f32x4*)(tile + (R0 + i) * 512 + c4) = (t >= 0 && t < T) ? xv[j] * rs[R0 + i] * g4 * s14 + s04 : zero4; }
    __syncthreads();
    float s = 0.f;
#pragma unroll
    for (int j = 0; j < WIN; ++j) s += tile[(R0 + j) * 512 + c];
#pragma unroll 4
    for (int i = 0; i < 32; ++i) { const int t = t0 + i, lo = max(t - LEFT, 0), hi = min(t + RIGHT + 1, T);
        const float o = s * __builtin_amdgcn_rcpf((float)(hi - lo)) - tile[(8 + i) * 512 + c];
        out[(size_t)(sb + t) * PK + col] = (bf16_t)f2bf(o);
        if (i < 31) s += tile[(8 + i + RIGHT + 1) * 512 + c] - tile[(8 + i - LEFT) * 512 + c]; }
    __syncthreads();
}
__device__ __forceinline__ void phase_pool_elem(const float* x_lo, const float* x_hi, const bf16_t* xb, RowSq rowsq, const float* gain, const float* mod_sh, const float* mod_sc, bf16_t* out, LAS unsigned char* lds) {
    LAS float* tile = (LAS float*)lds;
    LAS float* rs = (LAS float*)(lds + 48 * 512 * 4);
    const int c = opaque_tid();
    const int NI = (M / 32) * 4, G = gridDim.x; const bool xl = (G & 7) == 0 && (NI % G) == 0;
    const int nrnd = (NI + G - 1) / G;
    for (int rnd = 0; rnd < nrnd; ++rnd) {
        int item = (int)blockIdx.x + rnd * G; if (item >= NI) break;
        if (xl) { const int x = blockIdx.x & 7, j = blockIdx.x >> 3, per = NI / 8, wpx = G / 8; item = x * per + rnd * wpx + j; }
        const int chunk = item >> 2, gi = item & 3;
        if (gi == 0) pool_item<0>(x_lo, x_hi, xb, rowsq, gain, mod_sh, mod_sc, out, tile, rs, chunk, c);
        else if (gi == 1) pool_item<1>(x_lo, x_hi, xb, rowsq, gain, mod_sh, mod_sc, out, tile, rs, chunk, c);
        else if (gi == 2) pool_item<2>(x_lo, x_hi, xb, rowsq, gain, mod_sh, mod_sc, out, tile, rs, chunk, c);
        else pool_item<3>(x_lo, x_hi, xb, rowsq, gain, mod_sh, mod_sc, out, tile, rs, chunk, c);
    }
}

__device__ __forceinline__ void phase_conv_fix(const float* halo, const float* cw, const float* cb, bf16_t* act) {
    const int tid = opaque_tid();
    for (int i = blockIdx.x * NTHREADS + tid; i < 56 * (FF / 4); i += gridDim.x * NTHREADS) {
        const int bd = i / (FF / 4), c = (i % (FF / 4)) * 4, tA = 16 + 8 * (bd / 7) + (bd % 7), tB = tA + 1;
        const int ug = (c >> 7) * 256 + (c & 127);
        f32x4 wg[3], wv[3];
#pragma unroll
        for (int j = 0; j < 3; ++j) { wg[j] = *(const f32x4*)(cw + (size_t)j * FF2 + c); wv[j] = *(const f32x4*)(cw + (size_t)j * FF2 + FF + c); }
        const f32x4 bg = *(const f32x4*)(cb + c), bv = *(const f32x4*)(cb + FF + c);
        const float* hA = halo + (size_t)tA * 4 * FF2 + ug; const float* hB = halo + (size_t)tB * 4 * FF2 + ug;
        const f32x4 g254 = *(const f32x4*)(hA + 2 * FF2), g255 = *(const f32x4*)(hA + 3 * FF2), g0 = *(const f32x4*)(hB), g1 = *(const f32x4*)(hB + FF2);
        const f32x4 v254 = *(const f32x4*)(hA + 2 * FF2 + 128), v255 = *(const f32x4*)(hA + 3 * FF2 + 128), v0 = *(const f32x4*)(hB + 128), v1 = *(const f32x4*)(hB + FF2 + 128);
        const f32x4 uga = wg[0] * g254 + wg[1] * g255 + wg[2] * g0 + bg, uva = wv[0] * v254 + wv[1] * v255 + wv[2] * v0 + bv;
        const f32x4 ugb = wg[0] * g255 + wg[1] * g0 + wg[2] * g1 + bg, uvb = wv[0] * v255 + wv[1] * v0 + wv[2] * v1 + bv;
        f32x4 oa, ob;
#pragma unroll
        for (int e2 = 0; e2 < 4; ++e2) { oa[e2] = siluf_(uga[e2]) * uva[e2]; ob[e2] = siluf_(ugb[e2]) * uvb[e2]; }
        *(u32x2*)(act + ((size_t)tA * 256 + 255) * PF + c) = f32_to_bf4(oa);
        *(u32x2*)(act + ((size_t)tB * 256) * PF + c) = f32_to_bf4(ob);
    }
}

__device__ __forceinline__ void phase_rwkv_shift(const bf16_t* xb, RowSq rowsq, const float* gain, const float* mod_sh, const float* mod_sc, const float* mu, bf16_t* X6, LAS unsigned char* lds) {
    LAS float* rs = (LAS float*)lds;
    const int tid = opaque_tid(), c = 4 * tid;
    for (int item = blockIdx.x; item < M / 16; item += gridDim.x) {
        const int m0 = item * 16; int sb, T; if (m0 < M_P) { sb = m0 & ~(T_P - 1); T = T_P; } else { sb = M_P + ((m0 - M_P) & ~(T_S - 1)); T = T_S; }
        const int t0 = m0 - sb, cond = cond_of_row(m0);
        __syncthreads();
        rows_rstd(rowsq, sb, T, t0 - 1, 18, rs, tid);
        f32x4 xv[18];
#pragma unroll
        for (int i = 0; i < 18; ++i) { const int t = t0 - 1 + i, tc = min(max(t, 0), T - 1); xv[i] = bf4_to_f32(*(const u32x2*)(xb + (size_t)(sb + tc) * PK + c)); }
        const f32x4 g = *(const f32x4*)(gain + c), s1 = 1.f + *(const f32x4*)(mod_sc + (size_t)cond * MODW + c), s0 = *(const f32x4*)(mod_sh + (size_t)cond * MODW + c);
        f32x4 muv[6];
#pragma unroll
        for (int i = 0; i < 6; ++i) muv[i] = *(const f32x4*)(mu + i * DM + c);
        __syncthreads();
        const f32x4 zero = {0.f, 0.f, 0.f, 0.f};
#pragma unroll
        for (int i = 0; i < 18; ++i) { const int t = t0 - 1 + i; xv[i] = (t >= 0 && t < T) ? (xv[i] * rs[i] * g) * s1 + s0 : zero; }
#pragma unroll
        for (int i = 0; i < 16; ++i) { const f32x4 hc = xv[i + 1], xx = 0.5f * (xv[i] + xv[i + 2]) - hc; const size_t off = (size_t)(m0 + i) * PK + c;
#pragma unroll
            for (int k = 0; k < 6; ++k) *(u32x2*)(X6 + (size_t)k * M * PK + off) = f32_to_bf4(hc + xx * muv[k]); }
    }
}

__device__ __forceinline__ float dpp_ror4(float x)  { return __builtin_bit_cast(float, __builtin_amdgcn_update_dpp(0, __builtin_bit_cast(int, x), 0x124, 0xF, 0xF, true)); }
__device__ __forceinline__ float dpp_ror12(float x) { return __builtin_bit_cast(float, __builtin_amdgcn_update_dpp(0, __builtin_bit_cast(int, x), 0x12C, 0xF, 0xF, true)); }
__device__ __forceinline__ void phase_qk_norm_rope(bf16_t* QKV, const float* qn, const float* kn, float* out_ck, float* out_cv, LAS unsigned char* lds) {
    const int tid = opaque_tid(), lane = tid & 63, gw = blockIdx.x * NWAVES + (tid >> 6), NGW = gridDim.x * NWAVES;
    LAS f32x2* tab = (LAS f32x2*)lds;
    for (int o = tid; o < 64 * 32; o += NTHREADS) { const int pos = o >> 5, i = o & 31; float sn, cs; sincosf((float)pos * exp2f(-(float)i * (13.287712379549449f / 32.f)), &sn, &cs); tab[o] = (f32x2){cs, sn}; }
    __syncthreads();
    const int li = lane & 15, g4 = lane >> 4, axis = li >> 3, ib = (li & 3) * 8;
    const bool hi_half = (li & 4) != 0;
    f32x4 qw[2], kw[2];
#pragma unroll
    for (int u = 0; u < 2; ++u) { qw[u] = *(const f32x4*)(qn + 8 * li + 4 * u); kw[u] = *(const f32x4*)(kn + 8 * li + 4 * u); }
    for (int m = gw; m < M; m += NGW) {
        const bool samp = m >= M_P; bf16_t* row = QKV + (size_t)m * PQ + 8 * lane;
        u32x4 ch[6];
#pragma unroll
        for (int j = 0; j < 6; ++j) ch[j] = *(const u32x4*)(row + 512 * j);
        f32x2 cs8[8];
        if (samp) { const int t = (m - M_P) & (T_S - 1), pos = axis == 0 ? (t >> 6) : (t & 63);
#pragma unroll
            for (int e2 = 0; e2 < 8; ++e2) cs8[e2] = tab[pos * 32 + ib + e2]; }
#pragma unroll
        for (int j = 0; j < 5; ++j) {
            float xv[8];
#pragma unroll
            for (int p = 0; p < 4; ++p) { xv[2 * p] = bflo(ch[j][p]); xv[2 * p + 1] = bfhi(ch[j][p]); }
            float ss = 0.f;
#pragma unroll
            for (int e2 = 0; e2 < 8; ++e2) ss += xv[e2] * xv[e2];
            const float rstd = rsqrtf(row16_sum(ss) * (1.f / 128.f) + NORM_EPS);
#pragma unroll
            for (int e2 = 0; e2 < 8; ++e2) xv[e2] *= rstd * (j < 4 ? qw[e2 >> 2][e2 & 3] : kw[e2 >> 2][e2 & 3]);
            if (!samp && j == 4) { float* ck = out_ck + (size_t)m * 512 + g4 * 128 + 8 * li;
                *(f32x4*)ck = (f32x4){xv[0], xv[1], xv[2], xv[3]}; *(f32x4*)(ck + 4) = (f32x4){xv[4], xv[5], xv[6], xv[7]}; }
            if (samp) {
#pragma unroll
                for (int e2 = 0; e2 < 8; ++e2) { const float pa = __shfl_xor(xv[e2], 4);
                    xv[e2] = xv[e2] * cs8[e2].x + (hi_half ? pa : -pa) * cs8[e2].y; } }
            u32x4 w; w.x = pk2(xv[0], xv[1]); w.y = pk2(xv[2], xv[3]); w.z = pk2(xv[4], xv[5]); w.w = pk2(xv[6], xv[7]);
            *(u32x4*)(row + 512 * j) = w;
        }
        if (!samp) { float* cv = out_cv + (size_t)m * 512 + g4 * 128 + 8 * li;
            *(f32x4*)cv = (f32x4){bflo(ch[5].x), bfhi(ch[5].x), bflo(ch[5].y), bfhi(ch[5].y)}; *(f32x4*)(cv + 4) = (f32x4){bflo(ch[5].z), bfhi(ch[5].z), bflo(ch[5].w), bfhi(ch[5].w)}; }
    }
}

__device__ __forceinline__ float dpp_xor1(float x) { return __builtin_bit_cast(float, __builtin_amdgcn_update_dpp(0, __builtin_bit_cast(int, x), 0xB1, 0xF, 0xF, true)); }
__device__ __forceinline__ float dpp_xor2(float x) { return __builtin_bit_cast(float, __builtin_amdgcn_update_dpp(0, __builtin_bit_cast(int, x), 0x4E, 0xF, 0xF, true)); }

struct ScanArgs { const bf16_t* R; const bf16_t* Kb; const bf16_t* V; const float* DEC; const bf16_t* AA; const bf16_t* Gt; bf16_t* OFB; bf16_t* Y;
                  const float* state_in; float* state_out; const float* k_k; const float* k_a; const float* r_k; const float* ln_w; const float* ln_b; };

typedef __bf16 bf16x2_t_ __attribute__((ext_vector_type(2)));
__device__ __forceinline__ unsigned cvt_pk_bf16_(float lo, float hi) { const f32x2 v = {lo, hi}; const bf16x2_t_ b = __builtin_convertvector(v, bf16x2_t_); return __builtin_bit_cast(unsigned, b); }
__device__ __forceinline__ bf16x8 mk8(unsigned x, unsigned y, unsigned z, unsigned w) { u32x4 t = {x, y, z, w}; return __builtin_bit_cast(bf16x8, t); }
__device__ __forceinline__ bf16x8 mk4(u32x2 x) { return mk8(x.x, x.y, 0u, 0u); }
__device__ __forceinline__ bf16x8 mk44(u32x2 x, u32x2 y) { return mk8(x.x, x.y, y.x, y.y); }
__device__ __forceinline__ f32x4 mma(bf16x8 a, bf16x8 b, f32x4 c) { return __builtin_amdgcn_mfma_f32_16x16x32_bf16(a, b, c, 0, 0, 0); }
__device__ __forceinline__ f32x4 mma16(u32x2 a, u32x2 b, f32x4 c) { return __builtin_amdgcn_mfma_f32_16x16x16bf16_1k(__builtin_bit_cast(s16x4, a), __builtin_bit_cast(s16x4, b), c, 0, 0, 0); }
__device__ __forceinline__ void st_to_bf16(const f32x4 (&St)[4], bf16x8& s0, bf16x8& s1) {
    s0 = mk8(cvt_pk_bf16_(St[0].x, St[0].y), cvt_pk_bf16_(St[0].z, St[0].w), cvt_pk_bf16_(St[1].x, St[1].y), cvt_pk_bf16_(St[1].z, St[1].w));
    s1 = mk8(cvt_pk_bf16_(St[2].x, St[2].y), cvt_pk_bf16_(St[2].z, St[2].w), cvt_pk_bf16_(St[3].x, St[3].y), cvt_pk_bf16_(St[3].z, St[3].w));
}
constexpr int TKP = 144;
constexpr int CH_WRAW = 0, CH_AT = 4096, CH_RT = CH_AT + 16 * TKP, CH_BT = CH_RT + 16 * TKP, CH_KT = CH_BT + 16 * TKP;
constexpr int KSP = 36;
constexpr int CH_BHK = CH_KT + 16 * TKP, CH_KHK = CH_BHK + 64 * KSP, CH_VT = CH_KHK + 64 * KSP, CH_GC = CH_VT + 64 * KSP, CH_GA = CH_GC + 256, CH_DIAG = CH_GA + 2048, CH_BYTES = ((CH_DIAG + 512 + 511) / 512) * 512;
static_assert(4 * CH_BYTES <= 131072 && CH_GC % 16 == 0 && CH_GA % 16 == 0 && CH_DIAG % 16 == 0, "scan LDS");
__device__ __forceinline__ u32x2 lds_ld2(const LAS unsigned char* p) { const LAS unsigned* q = (const LAS unsigned*)p; return (u32x2){q[0], q[1]}; }
#define SCAN_BAR() do { asm volatile("s_waitcnt lgkmcnt(0)" ::: "memory"); __builtin_amdgcn_s_barrier(); asm volatile("" ::: "memory"); } while (0)

__device__ __forceinline__ void phase_scan(const ScanArgs& S, LAS unsigned char* lds) {
    const int tid = opaque_tid(), dir = tid >> 8, lt = tid & 255, wv = lt >> 6, lane = tid & 63, i16 = lane & 15, v = i16 + 16 * wv, q = lane >> 4;
    const int ps = lt >> 4, kg = lt & 15;
    const int swv = __builtin_amdgcn_readfirstlane(wv);
    for (int i = tid; i < 4 * 12 * 64; i += NTHREADS) *(LAS float*)(lds + (i / 768) * CH_BYTES + CH_WRAW + (i % 768) * 4) = 1.f;
    __syncthreads();
    for (int it = blockIdx.x; it < 256 + 512; it += gridDim.x) {
        const bool samp = it < 256; int b, h, T, row0;
        if (samp) { b = it >> 5; h = it & 31; T = T_S; row0 = M_P + b * T_S; } else { const int j = it - 256; b = j >> 5; h = j & 31; T = T_P; row0 = b * T_P; }
        f32x4 St[4];
        if (samp) { const float* sp = S.state_in + ((size_t)((b * 2 + dir) * 32 + h)) * 4096 + v * 64 + 4 * q;
#pragma unroll
            for (int kt = 0; kt < 4; ++kt) St[kt] = *(const f32x4*)(sp + 16 * kt); }
        else {
#pragma unroll
            for (int kt = 0; kt < 4; ++kt) St[kt] = (f32x4){0.f, 0.f, 0.f, 0.f}; }
        bf16x8 sb0, sb1; st_to_bf16(St, sb0, sb1);
        const int hc = h * 64 + 4 * kg;
        const f32x4 kkw = *(const f32x4*)(S.k_k + hc), kaw = *(const f32x4*)(S.k_a + hc);
        const int nchunk = T / 16;
        struct PF { u32x2 r, k, v, a; f32x4 w; };
        const int sdir = __builtin_amdgcn_readfirstlane(dir);
        const char* pR = (const char*)S.R; const char* pK = (const char*)S.Kb; const char* pV = (const char*)S.V;
        const char* pA = (const char*)(S.AA + (size_t)sdir * M * PK); const char* pW = (const char*)(S.DEC + (size_t)sdir * M * PK);
        const int cstep = (sdir == 0 ? 16 : -16) * PK * 2;
        unsigned poff = (unsigned)(((row0 + (dir == 0 ? ps : T - 1 - ps)) * PK + hc) * 2);
        auto prefetch = [&](PF& p) {
            p.r = *(const u32x2*)(pR + poff); p.k = *(const u32x2*)(pK + poff); p.v = *(const u32x2*)(pV + poff);
            p.a = *(const u32x2*)(pA + poff); p.w = *(const f32x4*)(pW + 2u * poff); poff += (unsigned)cstep; };
        f32x4 gmask;
#pragma unroll
        for (int r = 0; r < 4; ++r) { const int j = 4 * q + r, t = i16; gmask[r] = (wv == 0 ? (q < (t >> 2)) : (wv == 1 ? (j < t) : (j <= t))) ? 1.f : 0.f; }
        PF pfA, pfB;
        prefetch(pfA); prefetch(pfB);
        char* pO = (char*)(S.OFB + (size_t)sdir * M * PK);
        const int rstep = (sdir == 0 ? 1 : -1) * PK * 2;
        unsigned ooff = (unsigned)(((row0 + (dir == 0 ? 4 * q : T - 1 - 4 * q)) * PK + h * 64 + v) * 2);
        auto do_chunk = [&](int c, PF& pf) {
            LAS unsigned char* B = lds + ((c & 1) * 2 + dir) * CH_BYTES;
            const f32x4 r4 = bf4_to_f32(pf.r), k4 = bf4_to_f32(pf.k), v4 = bf4_to_f32(pf.v), a4 = bf4_to_f32(pf.a), w4 = pf.w;
            const f32x4 kv = k4 * kkw; float ss = (kv.x * kv.x + kv.y * kv.y) + (kv.z * kv.z + kv.w * kv.w);
            ss = row16_sum(ss);
            const float inv = fminf(__builtin_amdgcn_rsqf(ss), 1e12f);
            const f32x4 kk = kv * inv, kd = k4 * (1.f + (a4 - 1.f) * kaw), bb = kk * a4;
            f32x4 inc = w4, exw;
            {
                const f32x4 one = {1.f, 1.f, 1.f, 1.f}; f32x4 t;
#pragma unroll
                for (int e = 0; e < 4; ++e) t[e] = __shfl_up(inc[e], 16);
                inc *= (lane >= 16) ? t : one;
#pragma unroll
                for (int e = 0; e < 4; ++e) t[e] = __shfl_up(inc[e], 32);
                inc *= (lane >= 32) ? t : one;
#pragma unroll
                for (int e = 0; e < 4; ++e) t[e] = __shfl_up(inc[e], 16);
                exw = (lane >= 16) ? t : one;
                if (lane >= 48) {
                    for (int d = swv + 1; d < 4; ++d) *(LAS f32x4*)(B + CH_WRAW + (d * 3 + wv) * 256 + 16 * kg) = inc; }
            }
#pragma unroll
            for (int e = 0; e < 4; ++e) *(LAS bf16_t*)(B + CH_VT + (4 * kg + e) * KSP + 2 * ps) = (bf16_t)((e < 2 ? pf.v.x : pf.v.y) >> (16 * (e & 1)));
            SCAN_BAR();
            if (c + 2 < nchunk) prefetch(pf);
            {
                f32x4 wt[3];
#pragma unroll
                for (int u = 0; u < 3; ++u) wt[u] = *(const LAS f32x4*)(B + CH_WRAW + (wv * 3 + u) * 256 + 16 * kg);
                const f32x4 gp = ((exw * wt[0]) * wt[1]) * wt[2];
                const f32x4 g = gp * w4;
                f32x4 ig; ig.x = __builtin_amdgcn_rcpf(g.x); ig.y = __builtin_amdgcn_rcpf(g.y); ig.z = __builtin_amdgcn_rcpf(g.z); ig.w = __builtin_amdgcn_rcpf(g.w);
                const f32x4 ah = -kk * gp, bh = bb * ig, kh = kd * ig, rh = r4 * g;
                *(LAS u32x2*)(B + CH_AT + ps * TKP + 8 * kg) = f32_to_bf4(ah);
                *(LAS u32x2*)(B + CH_RT + ps * TKP + 8 * kg) = f32_to_bf4(rh);
                const u32x2 bhb = f32_to_bf4(bh), khb = f32_to_bf4(kh);
                *(LAS u32x2*)(B + CH_BT + ps * TKP + 8 * kg) = bhb;
                *(LAS u32x2*)(B + CH_KT + ps * TKP + 8 * kg) = khb;
                LAS unsigned char* pb = B + CH_BHK + (4 * kg) * KSP + 2 * ps; LAS unsigned char* pkh = B + CH_KHK + (4 * kg) * KSP + 2 * ps;
                *(LAS bf16_t*)(pb) = (bf16_t)(bhb.x & 0xffffu); *(LAS bf16_t*)(pb + KSP) = (bf16_t)(bhb.x >> 16); *(LAS bf16_t*)(pb + 2 * KSP) = (bf16_t)(bhb.y & 0xffffu); *(LAS bf16_t*)(pb + 3 * KSP) = (bf16_t)(bhb.y >> 16);
                *(LAS bf16_t*)(pkh) = (bf16_t)(khb.x & 0xffffu); *(LAS bf16_t*)(pkh + KSP) = (bf16_t)(khb.x >> 16); *(LAS bf16_t*)(pkh + 2 * KSP) = (bf16_t)(khb.y & 0xffffu); *(LAS bf16_t*)(pkh + 3 * KSP) = (bf16_t)(khb.y >> 16);
                if (ps == 15) *(LAS f32x4*)(B + CH_GC + 16 * kg) = g;
            }
            SCAN_BAR();
            {
                const LAS unsigned char* X = B + ((wv & 1) ? CH_KT : CH_BT) + i16 * TKP + 16 * q; const LAS unsigned char* Y = B + ((wv >> 1) ? CH_RT : CH_AT) + i16 * TKP + 16 * q;
                f32x4 d = {0.f, 0.f, 0.f, 0.f};
                d = mma(*(const LAS bf16x8*)X, *(const LAS bf16x8*)Y, d);
                d = mma(*(const LAS bf16x8*)(X + 64), *(const LAS bf16x8*)(Y + 64), d);
                const int t = i16;
                if (wv == 0) {
                    LAS float* dg = (LAS float*)(B + CH_DIAG) + (q == (t >> 2) ? (q * 16 + (t & 3)) : 64 + lane);
#pragma unroll
                    for (int r = 0; r < 4; ++r) dg[q == (t >> 2) ? 4 * r : 0] = d[r]; }
                *(LAS u32x2*)(B + CH_GA + (wv * 64 + lane) * 8) = f32_to_bf4(d * gmask);
            }
            SCAN_BAR();
            {
                const LAS unsigned char* pa_ = B + CH_AT + i16 * TKP + 8 * q; const LAS unsigned char* pr_ = B + CH_RT + i16 * TKP + 8 * q;
                const bf16x8 zA0 = mk44(*(const LAS u32x2*)(pa_), *(const LAS u32x2*)(pa_ + 32)), zA1 = mk44(*(const LAS u32x2*)(pa_ + 64), *(const LAS u32x2*)(pa_ + 96));
                const bf16x8 rA0 = mk44(*(const LAS u32x2*)(pr_), *(const LAS u32x2*)(pr_ + 32)), rA1 = mk44(*(const LAS u32x2*)(pr_ + 64), *(const LAS u32x2*)(pr_ + 96));
                const f32x4 zero = {0.f, 0.f, 0.f, 0.f};
                f32x4 Z = mma(zA0, sb0, zero); Z = mma(zA1, sb1, Z);
                f32x4 O = mma(rA0, sb0, zero); O = mma(rA1, sb1, O);
                const u32x2 Bv = lds_ld2(B + CH_VT + v * KSP + 8 * q);
                const u32x2 gab = *(const LAS u32x2*)(B + CH_GA + (0 * 64 + lane) * 8), gka = *(const LAS u32x2*)(B + CH_GA + (1 * 64 + lane) * 8);
                const u32x2 gbr = *(const LAS u32x2*)(B + CH_GA + (2 * 64 + lane) * 8), gkr = *(const LAS u32x2*)(B + CH_GA + (3 * 64 + lane) * 8);
                Z = mma16(gka, Bv, Z);
                const f32x4 d0 = *(const LAS f32x4*)(B + CH_DIAG + (q * 4 + 0) * 16), d1 = *(const LAS f32x4*)(B + CH_DIAG + (q * 4 + 1) * 16), d2 = *(const LAS f32x4*)(B + CH_DIAG + (q * 4 + 2) * 16);
                f32x4 U = Z;
                U.y += d0.y * U.x; U.z += d0.z * U.x + d1.z * U.y; U.w += d0.w * U.x + d1.w * U.y + d2.w * U.z;
#pragma unroll
                for (int Q = 1; Q < 4; ++Q) {
                    U = mma16(gab, (u32x2){cvt_pk_bf16_(U.x, U.y), cvt_pk_bf16_(U.z, U.w)}, Z);
                    U.y += d0.y * U.x; U.z += d0.z * U.x + d1.z * U.y; U.w += d0.w * U.x + d1.w * U.y + d2.w * U.z;
                }
                const u32x2 Ub = {cvt_pk_bf16_(U.x, U.y), cvt_pk_bf16_(U.z, U.w)};
                O = mma16(gbr, Ub, O); O = mma16(gkr, Bv, O);
#pragma unroll
                for (int r = 0; r < 4; ++r) *(bf16_t*)(pO + (ooff + (unsigned)(r * rstep))) = (bf16_t)f2bf(O[r]);
                ooff += (unsigned)cstep;
#pragma unroll
                for (int kt = 0; kt < 4; ++kt) {
                    const u32x2 abh = lds_ld2(B + CH_BHK + (16 * kt + i16) * KSP + 8 * q), akh = lds_ld2(B + CH_KHK + (16 * kt + i16) * KSP + 8 * q);
                    f32x4 s = mma16(abh, Ub, St[kt]); s = mma16(akh, Bv, s);
                    St[kt] = s * *(const LAS f32x4*)(B + CH_GC + 4 * (16 * kt + 4 * q)); }
                st_to_bf16(St, sb0, sb1);
            }
        };
        for (int c = 0; c < nchunk; c += 2) { do_chunk(c, pfA); do_chunk(c + 1, pfB); }
        if (!samp) { float* sp = S.state_out + ((size_t)((b * 2 + dir) * 32 + h)) * 4096 + v * 64 + 4 * q;
#pragma unroll
            for (int kt = 0; kt < 4; ++kt) *(f32x4*)(sp + 16 * kt) = St[kt]; }
        asm volatile("s_waitcnt vmcnt(0)" ::: "memory");
        __syncthreads();
        {
            const int tk = tid >> 4, hc2 = h * 64 + 4 * (tid & 15);
            const f32x4 lw = *(const f32x4*)(S.ln_w + hc2), lb = *(const f32x4*)(S.ln_b + hc2), ka = *(const f32x4*)(S.k_a + hc2), rk = *(const f32x4*)(S.r_k + hc2);
            struct OS { u32x2 of, ob, r, k, v, af, ab, g; };
            auto os_load = [&](size_t off) { OS q; q.of = *(const u32x2*)(S.OFB + off); q.ob = *(const u32x2*)(S.OFB + (size_t)M * PK + off); q.r = *(const u32x2*)(S.R + off); q.k = *(const u32x2*)(S.Kb + off);
                q.v = *(const u32x2*)(S.V + off); q.af = *(const u32x2*)(S.AA + off); q.ab = *(const u32x2*)(S.AA + (size_t)M * PK + off); q.g = *(const u32x2*)(S.Gt + off); return q; };
            auto os_finish = [&](const OS& q, size_t off) {
                const f32x4 o = bf4_to_f32(q.of) + bf4_to_f32(q.ob);
                const float mean = row16_sum((o.x + o.y) + (o.z + o.w)) * (1.f / 64.f);
                const f32x4 d = o - mean;
                const float var = row16_sum((d.x * d.x + d.y * d.y) + (d.z * d.z + d.w * d.w)) * (1.f / 64.f);
                const f32x4 on = d * rsqrtf(var + 64e-5f) * lw + lb;
                const f32x4 r4 = bf4_to_f32(q.r), k4 = bf4_to_f32(q.k), v4 = bf4_to_f32(q.v);
                const f32x4 af = bf4_to_f32(q.af), ab = bf4_to_f32(q.ab), g4 = bf4_to_f32(q.g);
                const f32x4 kds = k4 * ((1.f + (af - 1.f) * ka) + (1.f + (ab - 1.f) * ka));
                const f32x4 pr4 = r4 * kds * rk;
                const float bon = row16_sum((pr4.x + pr4.y) + (pr4.z + pr4.w));
                *(u32x2*)(S.Y + off) = f32_to_bf4((on + bon * v4) * g4); };
            for (int t = tk; t < T; t += 64) {
                const size_t off0 = (size_t)(row0 + t) * PK + hc2, off1 = off0 + (size_t)32 * PK;
                const OS q0 = os_load(off0), q1 = os_load(off1);
                __builtin_amdgcn_sched_barrier(0);
                os_finish(q0, off0); os_finish(q1, off1); }
        }
        __syncthreads();
    }
}

namespace attn {
constexpr int D = 128, NW = 8, QBLK = 32, KVBLK = 64;
constexpr float SCALE = 0.088388347648318440f;
constexpr float THR = 8.f;
constexpr size_t SHM_V = KVBLK * D * 2, SHM_K = KVBLK * D * 2, SHM_ATTN = 2 * SHM_V + 2 * SHM_K + NW * 64 * 4;
#define KSWZ(row, colB) ((row) * 256 + ((colB) ^ (((row) & 7) << 4)))
#define SBAR() __builtin_amdgcn_sched_barrier(0)
__device__ __forceinline__ int crow(int r, int hi) { return (r & 3) + 8 * (r >> 2) + 4 * hi; }
__device__ __forceinline__ unsigned cvtpk(float lo, float hi) { unsigned r; asm volatile("v_cvt_pk_bf16_f32 %0, %1, %2" : "=v"(r) : "v"(lo), "v"(hi)); return r; }

__device__ __forceinline__ void partialSM(f32x16& p0, f32x16& p1, float& m_reg, float& mn, float& alpha) {
    constexpr float C = SCALE * 1.4426950408889634f;
    float pmax = p0[0];
#pragma unroll
    for (int r = 1; r < 16; ++r) pmax = fmaxf(pmax, p0[r]);
#pragma unroll
    for (int r = 0; r < 16; ++r) pmax = fmaxf(pmax, p1[r]);
    { auto rr = __builtin_amdgcn_permlane32_swap(__float_as_uint(pmax), __float_as_uint(pmax), false, false);
      pmax = fmaxf(__uint_as_float(rr[0]), __uint_as_float(rr[1])); }
    if (__builtin_expect(__all(pmax - m_reg <= THR / SCALE), 1)) { mn = m_reg; alpha = 1.f; }
    else { mn = fmaxf(m_reg, pmax); alpha = __builtin_amdgcn_exp2f((m_reg - mn) * C); m_reg = mn; }
    const float mnC = -mn * C;
#pragma unroll
    for (int r = 0; r < 16; ++r) p0[r] = fmaf(p0[r], C, mnC);
#pragma unroll
    for (int r = 0; r < 16; ++r) p1[r] = fmaf(p1[r], C, mnC);
#pragma unroll
    for (int r = 0; r < 16; ++r) p0[r] = __builtin_amdgcn_exp2f(p0[r]);
}
__device__ __forceinline__ void finishSM(f32x16& p0, f32x16& p1, float alpha, float& l_reg, bf16x8& pa0, bf16x8& pa1, bf16x8& pa2, bf16x8& pa3) {
#pragma unroll
    for (int r = 0; r < 16; ++r) p1[r] = __builtin_amdgcn_exp2f(p1[r]);
    float ps = 0;
#pragma unroll
    for (int r = 0; r < 16; ++r) ps += p0[r];
#pragma unroll
    for (int r = 0; r < 16; ++r) ps += p1[r];
    { auto rr = __builtin_amdgcn_permlane32_swap(__float_as_uint(ps), __float_as_uint(ps), false, false);
      ps = __uint_as_float(rr[0]) + __uint_as_float(rr[1]); }
    l_reg = l_reg * alpha + ps;
#define PK4(P, BASE, OUT) do { unsigned a0 = cvtpk(P[BASE + 0], P[BASE + 1]), a1 = cvtpk(P[BASE + 2], P[BASE + 3]);   \
    unsigned b0 = cvtpk(P[BASE + 4], P[BASE + 5]), b1 = cvtpk(P[BASE + 6], P[BASE + 7]);                              \
    auto r0 = __builtin_amdgcn_permlane32_swap(a0, b0, false, false); auto r1 = __builtin_amdgcn_permlane32_swap(a1, b1, false, false); \
    u32x4 w = {r0[0], r1[0], r0[1], r1[1]}; OUT = __builtin_bit_cast(bf16x8, w); } while (0)
    PK4(p0, 0, pa0); PK4(p0, 8, pa1); PK4(p1, 0, pa2); PK4(p1, 8, pa3);
#undef PK4
}
__device__ __forceinline__ void qkt(f32x16& p0, f32x16& p1, const LAS char* Ks, const bf16x8* qr, int r32, int hi) {
    p0 = f32x16{}; p1 = f32x16{};
#pragma unroll
    for (int d0 = 0; d0 < 8; ++d0) { const int cb = (d0 * 16 + hi * 8) * 2;
        const bf16x8 b0 = *(const LAS bf16x8*)(Ks + KSWZ(r32, cb));
        const bf16x8 b1 = *(const LAS bf16x8*)(Ks + KSWZ(32 + r32, cb));
        p0 = __builtin_amdgcn_mfma_f32_32x32x16_bf16(b0, qr[d0], p0, 0, 0, 0);
        p1 = __builtin_amdgcn_mfma_f32_32x32x16_bf16(b1, qr[d0], p1, 0, 0, 0); }
}
__device__ __forceinline__ void band_mask(f32x16& p0, f32x16& p1, int kt0, int qpos, int hi) {
#pragma unroll
    for (int r = 0; r < 16; ++r) { const int d0 = qpos - (kt0 + crow(r, hi)), d1 = d0 - 32;
        if (d0 > 128 || d0 < -128) p0[r] = -1e30f;
        if (d1 > 128 || d1 < -128) p1[r] = -1e30f; }
}
__device__ __forceinline__ int v_st(int k, int c) { const int kk = (k & ~0xC) | ((k & 4) << 1) | ((k & 8) >> 1); return ((kk >> 3) * 4 + (c >> 5)) * 512 + ((kk & 7) * 32 + (c & 31)) * 2; }
__device__ __forceinline__ int v_rd_base(int lane) { return ((lane & 3) << 3) | (((lane >> 2) & 3) << 6) | (((lane >> 4) & 1) << 5) | (((lane >> 5) & 1) << 8); }
constexpr int v_rd_off(int d0, int ks, int half) { return d0 * 512 + ks * 4096 + half * 2048; }
template <int OFF> __device__ __forceinline__ s16x4 tr_read(int vb) {
    s16x4 r; asm volatile("ds_read_b64_tr_b16 %0, %1 offset:%2" : "=&v"(r) : "v"(vb), "i"(OFF) : "memory"); return r;
}
template <int D0> __device__ __forceinline__ void pv_one(f32x16& od, int vb, bf16x8 pa0, bf16x8 pa1, bf16x8 pa2, bf16x8 pa3) {
    const s16x4 l0 = tr_read<v_rd_off(D0, 0, 0)>(vb), h0 = tr_read<v_rd_off(D0, 0, 1)>(vb), l1 = tr_read<v_rd_off(D0, 1, 0)>(vb), h1 = tr_read<v_rd_off(D0, 1, 1)>(vb);
    const s16x4 l2 = tr_read<v_rd_off(D0, 2, 0)>(vb), h2 = tr_read<v_rd_off(D0, 2, 1)>(vb), l3 = tr_read<v_rd_off(D0, 3, 0)>(vb), h3 = tr_read<v_rd_off(D0, 3, 1)>(vb);
    asm volatile("s_waitcnt lgkmcnt(0)" ::: "memory"); SBAR();
#define PK(L, H) (bf16x8){L[0], L[1], L[2], L[3], H[0], H[1], H[2], H[3]}
    od = __builtin_amdgcn_mfma_f32_32x32x16_bf16(pa0, PK(l0, h0), od, 0, 0, 0);
    od = __builtin_amdgcn_mfma_f32_32x32x16_bf16(pa1, PK(l1, h1), od, 0, 0, 0);
    od = __builtin_amdgcn_mfma_f32_32x32x16_bf16(pa2, PK(l2, h2), od, 0, 0, 0);
    od = __builtin_amdgcn_mfma_f32_32x32x16_bf16(pa3, PK(l3, h3), od, 0, 0, 0);
#undef PK
}
__device__ __forceinline__ void pv_d0(f32x16* o, int vb, bf16x8 pa0, bf16x8 pa1, bf16x8 pa2, bf16x8 pa3) {
    pv_one<0>(o[0], vb, pa0, pa1, pa2, pa3); pv_one<1>(o[1], vb, pa0, pa1, pa2, pa3); pv_one<2>(o[2], vb, pa0, pa1, pa2, pa3); pv_one<3>(o[3], vb, pa0, pa1, pa2, pa3);
}

struct UnitDesc {
    const bf16_t* q;
    const bf16_t* ctxK; const bf16_t* ctxV;
    const bf16_t* bandK; const bf16_t* bandV;
    bf16_t* o;
    int nctx, band_lo, nband, q0, masked, head0;
};

__device__ __forceinline__ void attn_unit(const UnitDesc& U, const float* sink, LAS char* lds) {
    const int tid = opaque_tid(), wid = tid >> 6, lane = tid & 63, r32 = lane & 31, hi = lane >> 5;
    LAS char* V_lds = lds; LAS char* K_lds = lds + 2 * SHM_V;
    LAS float* wsx = (LAS float*)(lds + 2 * SHM_V + 2 * SHM_K) + wid * 64; LAS float* li_l = wsx; LAS float* al_l = wsx + 32;
    float m_reg = -1e30f, l_reg = 0; f32x16 o[4] = {}; bf16x8 qr[8];
    const int head = U.head0 + (wid >> 2), qrow = 32 * (wid & 3) + r32, qpos = U.q0 + qrow;
    const bf16_t* Qw = U.q + (size_t)qrow * PQ + head * 128 + hi * 8;
#pragma unroll
    for (int d0 = 0; d0 < 8; ++d0) qr[d0] = *(const bf16x8*)(Qw + d0 * 16);
    const int sr = tid >> 4, sc = (tid & 15) * 8, vst0 = v_st(sr, sc), vst1 = v_st(32 + sr, sc);
    const int vb0 = (int)(unsigned)(uintptr_t)V_lds + v_rd_base(lane);
    bf16x8 s_vs0[2], s_vs1[2], s_ks0[2], s_ks1[2];
    const int NT = U.nctx + U.nband;
#define TSRC(j, kp, vp, ld) const bf16_t* kp; const bf16_t* vp; int ld; do { if ((j) < U.nctx) { kp = U.ctxK + (size_t)(j) * 64 * 512; vp = U.ctxV + (size_t)(j) * 64 * 512; ld = 512; } \
        else { const size_t _o = (size_t)(U.band_lo + ((j) - U.nctx) * 64) * PQ; kp = U.bandK + _o; vp = U.bandV + _o; ld = PQ; } } while (0)
#define SLOAD(i, j) do { TSRC(j, _kp, _vp, _ld); s_vs0[i] = *(const bf16x8*)(_vp + (size_t)sr * _ld + sc); s_vs1[i] = *(const bf16x8*)(_vp + (size_t)(32 + sr) * _ld + sc); \
        s_ks0[i] = *(const bf16x8*)(_kp + (size_t)sr * _ld + sc); s_ks1[i] = *(const bf16x8*)(_kp + (size_t)(32 + sr) * _ld + sc); } while (0)
#define SWRITE(b, i) do { *(LAS bf16x8*)(V_lds + (b) * SHM_V + vst0) = s_vs0[i]; *(LAS bf16x8*)(V_lds + (b) * SHM_V + vst1) = s_vs1[i]; const int kc = sc * 2; \
        *(LAS bf16x8*)(K_lds + (b) * SHM_K + KSWZ(sr, kc)) = s_ks0[i]; *(LAS bf16x8*)(K_lds + (b) * SHM_K + KSWZ(32 + sr, kc)) = s_ks1[i]; } while (0)
#define SWAIT() asm volatile("s_waitcnt vmcnt(4)" ::: "memory")
#define RESC(a) do { if (__any((a) < 1.f)) { if (hi == 0) al_l[r32] = (a); asm volatile("s_waitcnt lgkmcnt(0)" ::: "memory"); \
        _Pragma("unroll") for (int d = 0; d < 4; ++d) _Pragma("unroll") for (int r = 0; r < 16; ++r) o[d][r] *= al_l[crow(r, hi)]; } } while (0)
#define MASK(p0, p1, j) do { if (U.masked && (j) >= U.nctx) band_mask(p0, p1, U.band_lo + ((j) - U.nctx) * 64, qpos, hi); } while (0)
    f32x16 pA0, pA1, pB0, pB1; float mnA, mnB, alA, alB; bf16x8 pa0, pa1, pa2, pa3;
    constexpr int SE = 0, SO = 1;
    SLOAD(SE, 0); asm volatile("s_waitcnt vmcnt(0)" ::: "memory"); SWRITE(0, SE); __syncthreads();
    qkt(pA0, pA1, K_lds, qr, r32, hi); MASK(pA0, pA1, 0); partialSM(pA0, pA1, m_reg, mnA, alA);
    SLOAD(SO, 1); if (2 < NT) SLOAD(SE, 2);
    SWAIT(); SWRITE(1, SO); __syncthreads();
    for (int j = 1; j + 1 < NT; j += 2) {
        SBAR(); qkt(pB0, pB1, K_lds + SHM_K, qr, r32, hi); MASK(pB0, pB1, j);
        finishSM(pA0, pA1, alA, l_reg, pa0, pa1, pa2, pa3); SBAR();
        SLOAD(SO, j + 2); SBAR();
        pv_d0(o, vb0, pa0, pa1, pa2, pa3); partialSM(pB0, pB1, m_reg, mnB, alB);
        __syncthreads(); SWAIT(); SWRITE(0, SE);
        RESC(alB); __syncthreads();
        SBAR(); qkt(pA0, pA1, K_lds, qr, r32, hi); MASK(pA0, pA1, j + 1);
        finishSM(pB0, pB1, alB, l_reg, pa0, pa1, pa2, pa3); SBAR();
        if (j + 3 < NT) SLOAD(SE, j + 3); SBAR();
        pv_d0(o, vb0 + (int)SHM_V, pa0, pa1, pa2, pa3); partialSM(pA0, pA1, m_reg, mnA, alA);
        __syncthreads(); SWAIT(); SWRITE(1, SO);
        RESC(alA); __syncthreads();
    }
    SBAR(); qkt(pB0, pB1, K_lds + SHM_K, qr, r32, hi); MASK(pB0, pB1, NT - 1);
    finishSM(pA0, pA1, alA, l_reg, pa0, pa1, pa2, pa3); SBAR();
    pv_d0(o, vb0, pa0, pa1, pa2, pa3); partialSM(pB0, pB1, m_reg, mnB, alB);
    __syncthreads(); RESC(alB);
    finishSM(pB0, pB1, alB, l_reg, pa0, pa1, pa2, pa3); SBAR();
    pv_d0(o, vb0 + (int)SHM_V, pa0, pa1, pa2, pa3);
    l_reg += __builtin_amdgcn_exp2f(sink[head] * 1.4426950408889634f - m_reg * (SCALE * 1.4426950408889634f));
    if (hi == 0) li_l[r32] = l_reg; asm volatile("s_waitcnt lgkmcnt(0)" ::: "memory");
    float rli[16];
#pragma unroll
    for (int r = 0; r < 16; ++r) rli[r] = __builtin_amdgcn_rcpf(li_l[crow(r, hi)]);
    bf16_t* Ow = U.o + (size_t)(32 * (wid & 3)) * PK + head * 128;
#pragma unroll
    for (int r = 0; r < 16; ++r) { const int orow = crow(r, hi);
#pragma unroll
        for (int d0 = 0; d0 < 4; ++d0) Ow[(size_t)orow * PK + d0 * 32 + r32] = (bf16_t)f2bf(o[d0][r] * rli[r]); }
#undef TSRC
#undef SLOAD
#undef SWRITE
#undef SWAIT
#undef RESC
#undef MASK
}
}

__device__ __forceinline__ void phase_attention(const bf16_t* QKV, const bf16_t* CKB, const bf16_t* CVB, const float* sink, bf16_t* AO, LAS unsigned char* lds) {
    for (int un = blockIdx.x; un < 1024 + 256; un += gridDim.x) {
        attn::UnitDesc U;
        if (un < 1024) { const int hp = un & 1, qb = (un >> 1) & 15, g = (un >> 5) & 3, b = un >> 7; const int row0 = M_P + b * T_S, q0 = qb * 128;
            U.q = QKV + (size_t)(row0 + q0) * PQ; U.ctxK = CKB + ((size_t)b * 512 * 4 + g) * 128; U.ctxV = CVB + ((size_t)b * 512 * 4 + g) * 128;
            U.bandK = QKV + (size_t)row0 * PQ + 2048 + g * 128; U.bandV = QKV + (size_t)row0 * PQ + 2560 + g * 128; U.o = AO + (size_t)(row0 + q0) * PK;
            const int lo = max(q0 - 128, 0), hiq = min(q0 + 256, T_S);
            U.nctx = 8; U.band_lo = lo; U.nband = (hiq - lo) / 64; U.q0 = q0; U.masked = 1; U.head0 = 4 * g + 2 * hp; }
        else { const int j = un - 1024; const int hp = j & 1, qb = (j >> 1) & 1, g = (j >> 2) & 3, b = j >> 4; const int row0 = b * T_P, q0 = qb * 128;
            U.q = QKV + (size_t)(row0 + q0) * PQ; U.ctxK = nullptr; U.ctxV = nullptr;
            U.bandK = QKV + (size_t)row0 * PQ + 2048 + g * 128; U.bandV = QKV + (size_t)row0 * PQ + 2560 + g * 128; U.o = AO + (size_t)(row0 + q0) * PK;
            U.nctx = 0; U.band_lo = 0; U.nband = 4; U.q0 = q0; U.masked = 0; U.head0 = 4 * g + 2 * hp; }
        __syncthreads();
        attn::attn_unit(U, sink, (LAS char*)lds);
    }
}

constexpr int PH_PER_LAYER = 12, N_PHASES = 1 + 4 * PH_PER_LAYER;
__host__ __device__ constexpr int kind_of_layer(int l) { return l % 3; }
__host__ __device__ inline bool phase_active(int ph) {
    if (ph == 0) return true;
    const int l = (ph - 1) / PH_PER_LAYER, j = (ph - 1) % PH_PER_LAYER, kind = kind_of_layer(l);
    if (j >= 6) return j <= 9;
    return kind == 0 ? j <= 1 : j <= 4;
}

__global__ void __launch_bounds__(NTHREADS, 2) mega_fwd(Args A) {
    extern __shared__ __attribute__((aligned(16))) unsigned char lds_raw[];
    LAS unsigned char* lds = (LAS unsigned char*)lds_raw;
    const int tid = threadIdx.x;
    unsigned char* ws = A.ws;
    volatile LAS unsigned* misc = (volatile LAS unsigned*)(lds + LDS_MISC);
    if (tid < 4) misc[tid] = 0u;
    __syncthreads();
    const int lo = A.ph_lo, hi = A.ph_hi;
    const bool multi = (hi - lo) > 1;
    XcdBarrier bar; bar.bar = (unsigned*)(ws + WS_CTL) + CW_BAR; bar.x = 0; bar.st = misc;
    if (multi) bar = xcd_barrier_post((unsigned*)(ws + WS_CTL) + CW_BAR, misc);
#ifndef SEL_KIND
#define SITE(k, j) true
#else
#define SITE(k, j) ((SEL_KIND) == (k) && (SEL_J) == (j))
#endif
#define IN(k) (lo <= (k) && (k) < hi)
#define SEAM() do { if (multi) xcd_barrier(bar); } while (0)

    float* X = A.out + OUT_X;
    bf16_t* XB = (bf16_t*)(ws + WS_XB);
    float* rowsq = (float*)(ws + WS_RSQ);
    const float* mod = (const float*)(ws + WS_MOD);

    if (SITE(8, 0) && IN(0)) for (int rep_ = 0; rep_ < REP_PRO; ++rep_) { phase_prologue(A, lds); SEAM(); }

    for (int l = 0; l < 4; ++l) {
        const int base = 1 + PH_PER_LAYER * l, kind = kind_of_layer(l), slot = l / 3;
        const float* modl = mod + (size_t)l * NCOND * MODW;
        const RowSq rs_in{rowsq + (size_t)(2 * l) * RSQ_PARTS * M, l == 0 ? 1 : RSQ_PARTS}; float* rs_mid = rowsq + (size_t)(2 * l + 1) * RSQ_PARTS * M; float* rs_out = rowsq + (size_t)(2 * l + 2) * RSQ_PARTS * M;
        const float* nmix = A.in[I_NMIX] + l * DM; const float* nffn = A.in[I_NFFN] + l * DM;
        if (kind == 0) {
            if (SITE(0, 0) && IN(base + 0)) for (int rep_ = 0; rep_ < REP_ELEM; ++rep_) { phase_pool_elem(A.in[I_XP], A.in[I_XS], l == 0 ? nullptr : XB, rs_in, nmix, modl, modl + DM, (bf16_t*)(ws + WS_H), lds); SEAM(); }
            if (SITE(0, 1) && IN(base + 1)) {
                ProbPool P{(const bf16_t*)(ws + WS_H), (const bf16_t*)(ws + WS_WPOOL) + (size_t)slot * DM * PPW, PK, PPW, 512, M / 256, 8};
                EpiResid E{X, XB, modl + 2 * DM, A.in[I_POOLS] + slot * DM, rs_mid, A.in[I_XP], A.in[I_XS], l == 0 ? 0 : 1};
                pg8::gemm_phase<EpiResid, ProbPool, true, true>(lds, P, E);
                SEAM(); }
        } else if (kind == 1) {
            if (SITE(1, 0) && IN(base + 0)) for (int rep_ = 0; rep_ < REP_ELEM; ++rep_) { phase_rwkv_shift(XB, rs_in, nmix, modl, modl + DM, A.in[I_MU], (bf16_t*)(ws + WS_X6), lds); SEAM(); }
            if (SITE(1, 1) && IN(base + 1)) for (int rep_ = 0; rep_ < REP_RW; ++rep_) {
                ProbRwkv1 P{(const bf16_t*)(ws + WS_X6), (const bf16_t*)(ws + WS_WR), (const bf16_t*)(ws + WS_WL1), PK, PK, DM, M / 256, 27};
                EpiRwkv1 E{(bf16_t*)(ws + WS_RKV), (bf16_t*)(ws + WS_L1)};
                pg8::gemm_phase<EpiRwkv1, ProbRwkv1, true, true>(lds, P, E);
                SEAM(); }
            if (SITE(1, 2) && IN(base + 2)) for (int rep_ = 0; rep_ < REP_RW * REP_G2; ++rep_) {
                ProbRwkv2 P{(const bf16_t*)(ws + WS_L1), (const bf16_t*)(ws + WS_WW2), (const bf16_t*)(ws + WS_WA2), (const bf16_t*)(ws + WS_WG2), PL1, PW2, 256, M / 256, 40};
                EpiRwkv2 E{(float*)(ws + WS_DEC), (bf16_t*)(ws + WS_AA), (bf16_t*)(ws + WS_G), A.in[I_W0], A.in[I_A0]};
                pg8::gemm_phase<EpiRwkv2, ProbRwkv2, true, true>(lds, P, E);
                SEAM(); }
            if (SITE(1, 3) && IN(base + 3)) for (int rep_ = 0; rep_ < REP_SCAN; ++rep_) {
                ScanArgs S{(const bf16_t*)(ws + WS_RKV), (const bf16_t*)(ws + WS_RKV + SZ_H), (const bf16_t*)(ws + WS_RKV + 2 * SZ_H), (const float*)(ws + WS_DEC), (const bf16_t*)(ws + WS_AA),
                           (const bf16_t*)(ws + WS_G), (bf16_t*)(ws + WS_OFB), (bf16_t*)(ws + WS_Y), A.in[I_STATE], A.out + OUT_STATE, A.in[I_KK], A.in[I_KA], A.in[I_RK], A.in[I_LNW], A.in[I_LNB]};
                phase_scan(S, lds);
                SEAM(); }
        } else {
            if (SITE(2, 0) && IN(base + 0)) for (int rep_ = 0; rep_ < REP_ELEM; ++rep_) { phase_normmod(XB, rs_in, nmix, modl, modl + DM, (bf16_t*)(ws + WS_H)); SEAM(); }
            if (SITE(2, 1) && IN(base + 1)) {
                ProbSimple P{(const bf16_t*)(ws + WS_H), (const bf16_t*)(ws + WS_WQKV), PK, PK, DM, M / 256, 12};
                EpiBf16 E{(bf16_t*)(ws + WS_QKVB), PQ};
                pg8::gemm_phase<EpiBf16, ProbSimple, true, true>(lds, P, E);
                SEAM(); }
            if (SITE(2, 2) && IN(base + 2)) { phase_qk_norm_rope((bf16_t*)(ws + WS_QKVB), A.in[I_QN], A.in[I_KN], A.out + OUT_CK, A.out + OUT_CV, lds); SEAM(); }
            if (SITE(2, 3) && IN(base + 3)) for (int rep_ = 0; rep_ < REP_ATTN; ++rep_) { phase_attention((const bf16_t*)(ws + WS_QKVB), (const bf16_t*)(ws + WS_CKB), (const bf16_t*)(ws + WS_CVB), A.in[I_SINK], (bf16_t*)(ws + WS_AOB), lds); SEAM(); }
        }
        if (SITE(7, 4) && kind != 0 && IN(base + 4)) {
            ProbSimple P{(const bf16_t*)(ws + (kind == 1 ? WS_Y : WS_AOB)), (const bf16_t*)(ws + (kind == 1 ? WS_WR + 3 * SZ_SQ : WS_WAO)), PK, PK, DM, M / 256, 8};
            EpiResid E{X, XB, modl + 2 * DM, nullptr, rs_mid, nullptr, nullptr, 1};
            pg8::gemm_phase<EpiResid, ProbSimple, true, true>(lds, P, E);
            if (l == 1) { const int G = gridDim.x, rem = (M / 256 * 8) % G, bx = blockIdx.x;
                if (rem == 0) convert_weights(A, lds, 2, 2, bx * NWAVES + (opaque_tid() >> 6), G * NWAVES);
                else if (bx >= rem) convert_weights(A, lds, 2, 2, (bx - rem) * NWAVES + (opaque_tid() >> 6), (G - rem) * NWAVES); }
            SEAM(); }
        if (SITE(9, 6) && IN(base + 6)) for (int rep_ = 0; rep_ < REP_ELEM; ++rep_) { phase_normmod(XB, RowSq{rs_mid, RSQ_PARTS}, nffn, modl + 3 * DM, modl + 4 * DM, (bf16_t*)(ws + WS_H)); SEAM(); }
        if (SITE(9, 7) && IN(base + 7)) for (int rep_ = 0; rep_ < REP_UP; ++rep_) {
            ProbSimple P{(const bf16_t*)(ws + WS_H), (const bf16_t*)(ws + WS_WUP + (size_t)l * SZ_UP), PK, PK, DM, M / 256, FF2 / 256};
            EpiUpConv E{(bf16_t*)(ws + WS_ACTB), (float*)(ws + WS_U), A.in[I_CONVW] + (size_t)l * 3 * FF2, A.in[I_CONVB] + (size_t)l * FF2, (LAS float*)(lds + 131072)};
            pg8::gemm_phase<EpiUpConv, ProbSimple, true, true>(lds, P, E);
            SEAM(); }
        if (SITE(9, 8) && IN(base + 8)) for (int rep_ = 0; rep_ < REP_CONV; ++rep_) { phase_conv_fix((const float*)(ws + WS_U), A.in[I_CONVW] + (size_t)l * 3 * FF2, A.in[I_CONVB] + (size_t)l * FF2, (bf16_t*)(ws + WS_ACTB)); SEAM(); }
        if (SITE(9, 9) && IN(base + 9)) {
            ProbSimple P{(const bf16_t*)(ws + WS_ACTB), (const bf16_t*)(ws + WS_WDN + (size_t)l * SZ_DN), PF, PF, FF, M / 256, 8};
            EpiResid E{X, XB, modl + 5 * DM, nullptr, rs_out, nullptr, nullptr, l == 3 ? 2 : 1};
            pg8::gemm_phase<EpiResid, ProbSimple, true, true>(lds, P, E);
            if (l < 3) {
                const int G = gridDim.x, rem = (M / 256 * 8) % G, bx = blockIdx.x;
                const int part = l == 2 ? 0 : 1;
                if (rem == 0) convert_weights(A, lds, l + 1, part, bx * NWAVES + (opaque_tid() >> 6), G * NWAVES);
                else if (bx >= rem) convert_weights(A, lds, l + 1, part, (bx - rem) * NWAVES + (opaque_tid() >> 6), (G - rem) * NWAVES); }
            SEAM(); }
    }
#undef IN
#undef SEAM
}

extern "C" void kernel_launch(void* const* d_in, const int* in_sizes, int n_in, void* d_out, int out_size, void* d_ws, size_t ws_size, hipStream_t stream) {
    static int grid = 0;
    if (grid == 0) {
        if (n_in != N_IN || (size_t)out_size != OUT_TOTAL || ws_size < WS_END) {
            fprintf(stderr, "kernel_launch: built for %d inputs, %zu outputs, >= %zu bytes of workspace; got n_in %d, out %d, ws %zu; nothing launched\n", (int)N_IN, (size_t)OUT_TOTAL, (size_t)WS_END, n_in, out_size, ws_size);
            grid = -1; return; }
        int dev = 0, cus = 0, per_cu = 0;
        if (hipGetDevice(&dev) != hipSuccess || hipDeviceGetAttribute(&cus, hipDeviceAttributeMultiprocessorCount, dev) != hipSuccess) { fprintf(stderr, "kernel_launch: device query failed\n"); grid = -1; return; }
        if (hipFuncSetAttribute((const void*)mega_fwd, hipFuncAttributeMaxDynamicSharedMemorySize, LDS_BYTES) != hipSuccess) { fprintf(stderr, "kernel_launch: hipFuncSetAttribute failed\n"); grid = -1; return; }
        if (hipOccupancyMaxActiveBlocksPerMultiprocessor(&per_cu, (const void*)mega_fwd, NTHREADS, LDS_BYTES) != hipSuccess || per_cu < 1)
            fprintf(stderr, "kernel_launch: note: occupancy query reports %d workgroups per CU\n", per_cu);
        (void)hipGetLastError();
        grid = cus;
    }
    if (grid < 0) return;
    unsigned char* ws = (unsigned char*)d_ws;
    (void)hipMemsetAsync(ws + WS_CTL, 0, CTL_BYTES, stream);
    Args a{};
    for (int i = 0; i < N_IN; ++i) a.in[i] = (const float*)d_in[i];
    a.out = (float*)d_out; a.ws = ws;
#if MK_ONE_LAUNCH
    a.ph_lo = 0; a.ph_hi = N_PHASES;
    hipLaunchKernelGGL(mega_fwd, dim3(grid), dim3(NTHREADS), LDS_BYTES, stream, a);
#else
    for (int ph = 0; ph < MK_MAX_PHASE; ++ph) {
        if (!phase_active(ph)) continue;
        a.ph_lo = ph; a.ph_hi = ph + 1;
        hipLaunchKernelGGL(mega_fwd, dim3(grid), dim3(NTHREADS), LDS_BYTES, stream, a);
    }
#endif
    const hipError_t le = hipPeekAtLastError();
    if (le != hipSuccess) fprintf(stderr, "kernel_launch: launch failed: %s\n", hipGetErrorName(le));
}
```

```cpp
#include <hip/hip_runtime.h>
#include <cstdio>
#include <cstdint>

#ifndef MK_ONE_LAUNCH
#define MK_ONE_LAUNCH 1
#endif

#ifndef MK_MAX_PHASE
#define MK_MAX_PHASE 49
#endif

#ifndef REP_PRO
#define REP_PRO 1
#endif
#ifndef REP_ADA
#define REP_ADA 1
#endif
#ifndef REP_TR
#define REP_TR 1
#endif
#ifndef REP_UP
#define REP_UP 1
#endif
#ifndef REP_CONV
#define REP_CONV 1
#endif
#ifndef REP_SCAN
#define REP_SCAN 1
#endif
#ifndef REP_ATTN
#define REP_ATTN 1
#endif
#ifndef REP_RW
#define REP_RW 1
#endif
#ifndef REP_ELEM
#define REP_ELEM 1
#endif
#ifndef REP_G2
#define REP_G2 1
#endif

#define LAS __attribute__((address_space(3)))
#define GAS __attribute__((address_space(1)))
typedef unsigned short bf16_t;
typedef short bf16x8 __attribute__((ext_vector_type(8)));
typedef short s16x4 __attribute__((ext_vector_type(4)));
typedef float f32x4 __attribute__((ext_vector_type(4)));
typedef float f32x2 __attribute__((ext_vector_type(2)));
typedef float f32x16 __attribute__((ext_vector_type(16)));
typedef unsigned u32x4 __attribute__((ext_vector_type(4)));
typedef unsigned u32x2 __attribute__((ext_vector_type(2)));

constexpr int DM = 2048, FF = 5632, FF2 = 11264;
constexpr int NB_P = 16, T_P = 256, NB_S = 8, T_S = 2048;
constexpr int M_P = NB_P * T_P, M_S = NB_S * T_S, M = M_P + M_S;
constexpr int NCOND = 9, MODW = 6 * DM;
constexpr int NTHREADS = 512, NWAVES = 8;
constexpr float NORM_EPS = 1e-6f;
constexpr int PK = DM + 64;
constexpr int PF = FF + 64;
constexpr int PQ = 3072 + 64;
constexpr int PL1 = 768 + 64;
constexpr int PW2 = 256 + 64;
constexpr int PPW = 512 + 64;

enum { I_XP = 0, I_XS, I_STATE, I_CK, I_CV, I_C, I_CCTX, I_ADAW, I_ADAB, I_NMIX, I_NFFN, I_UP, I_CONVW, I_CONVB, I_DOWN, I_POOLW, I_POOLS,
       I_MU, I_WR, I_WK, I_WV, I_W0, I_W1, I_W2, I_A0, I_A1, I_A2, I_G1, I_G2, I_KK, I_KA, I_RK, I_LNW, I_LNB, I_WO,
       I_QKV, I_QN, I_KN, I_SINK, I_AO, N_IN };

constexpr size_t OUT_X = 0;
constexpr size_t OUT_STATE = (size_t)M * DM;
constexpr size_t OUT_CK = OUT_STATE + (size_t)16 * 2 * 32 * 4096;
constexpr size_t OUT_CV = OUT_CK + (size_t)16 * 256 * 512;
constexpr size_t OUT_TOTAL = OUT_CV + (size_t)16 * 256 * 512;

constexpr size_t MiB = 1u << 20;
constexpr size_t WS_CTL = 0, CTL_BYTES = 64 * 1024;
constexpr int CW_BAR = 1024;
constexpr size_t WS_MOD = 2 * MiB;
constexpr int RSQ_PARTS = 32;
constexpr size_t WS_RSQ = 4 * MiB, SZ_RSQ = (size_t)RSQ_PARTS * M * 4;
constexpr size_t WS_W = 28 * MiB;
constexpr size_t SZ_UP = (size_t)FF2 * PK * 2, SZ_DN = (size_t)DM * PF * 2, SZ_SQ = (size_t)DM * PK * 2;
constexpr size_t WS_WUP = WS_W;
constexpr size_t WS_WDN = WS_WUP + 4 * SZ_UP;
constexpr size_t WS_WPOOL = WS_WDN + 4 * SZ_DN;
constexpr size_t WS_WR = WS_WPOOL + 2 * (size_t)DM * PPW * 2;
constexpr size_t WS_WL1 = WS_WR + 4 * SZ_SQ;
constexpr size_t WS_WW2 = WS_WL1 + (size_t)768 * PK * 2;
constexpr size_t WS_WA2 = WS_WW2 + (size_t)4096 * PW2 * 2;
constexpr size_t WS_WG2 = WS_WA2 + (size_t)4096 * PW2 * 2;
constexpr size_t WS_WQKV = WS_WG2 + (size_t)2048 * PW2 * 2;
constexpr size_t WS_WAO = WS_WQKV + (size_t)3072 * PK * 2;
constexpr size_t WS_CKB = WS_WAO + SZ_SQ;
constexpr size_t WS_CVB = WS_CKB + (size_t)8 * 512 * 512 * 2;
constexpr size_t WS_ACT = ((WS_CVB + (size_t)8 * 512 * 512 * 2 + MiB - 1) / MiB) * MiB;
constexpr size_t SZ_H = (size_t)M * PK * 2;
constexpr size_t WS_H = WS_ACT;
constexpr size_t WS_U = WS_H + SZ_H;
constexpr size_t WS_ACTB = WS_U + 16 * MiB;
constexpr size_t WS_FFN_END = WS_ACTB + (size_t)M * PF * 2;
constexpr size_t WS_X6 = WS_ACT;
constexpr size_t WS_DEC = WS_X6, WS_AA = WS_DEC + (size_t)2 * M * PK * 4;
constexpr size_t WS_RKV = WS_X6 + 6 * SZ_H;
constexpr size_t WS_L1 = WS_RKV + 3 * SZ_H;
constexpr size_t WS_G = WS_L1 + (size_t)M * PL1 * 2;
constexpr size_t WS_OFB = WS_G + SZ_H;
constexpr size_t WS_Y = WS_RKV + 2 * SZ_H;
constexpr size_t WS_XB = WS_OFB + 2 * SZ_H;
constexpr size_t WS_RWKV_END = WS_XB + SZ_H;
constexpr size_t WS_QKVB = WS_ACT + SZ_H;
constexpr size_t WS_AOB = WS_QKVB + (size_t)M * PQ * 2;
constexpr size_t WS_END = WS_RWKV_END > WS_FFN_END ? WS_RWKV_END : WS_FFN_END;
static_assert(WS_AA + (size_t)2 * M * PK * 2 == WS_RKV, "DEC + AA overlay the six shifted inputs exactly");
static_assert((size_t)80 * 4 * FF2 * 4 <= 16 * MiB && WS_END <= 1536 * MiB, "halo rows fit their slot; the whole map fits the guaranteed workspace (4 x the largest input tensor)");

constexpr int LDS_BYTES = 147456;
constexpr int LDS_MISC = 131072 + 8192;

typedef __bf16 bf16x2_hw __attribute__((ext_vector_type(2)));
__device__ __forceinline__ unsigned pk2(float lo, float hi) { const f32x2 v = {lo, hi}; const bf16x2_hw b = __builtin_convertvector(v, bf16x2_hw); return __builtin_bit_cast(unsigned, b); }
__device__ __forceinline__ unsigned f2bf(float f) { return pk2(f, f) & 0xffffu; }
__device__ __forceinline__ float bf2f(unsigned short b) { return __builtin_bit_cast(float, ((unsigned)b) << 16); }
__device__ __forceinline__ float bflo(unsigned w) { return __builtin_bit_cast(float, w << 16); }
__device__ __forceinline__ float bfhi(unsigned w) { return __builtin_bit_cast(float, w & 0xffff0000u); }
__device__ __forceinline__ f32x4 bf4_to_f32(u32x2 w) { return (f32x4){bflo(w.x), bfhi(w.x), bflo(w.y), bfhi(w.y)}; }
__device__ __forceinline__ u32x2 f32_to_bf4(f32x4 v) { u32x2 w; w.x = pk2(v.x, v.y); w.y = pk2(v.z, v.w); return w; }
__device__ __forceinline__ float wave_sum(float v) {
#pragma unroll
    for (int o = 1; o < 64; o <<= 1) v += __shfl_xor(v, o);
    return v;
}
#define DPP_ADD(x, ctrl) ((x) + __builtin_bit_cast(float, __builtin_amdgcn_update_dpp(0, __builtin_bit_cast(int, (x)), (ctrl), 0xF, 0xF, true)))
__device__ __forceinline__ float row16_sum(float v) {
    v = DPP_ADD(v, 0xB1); v = DPP_ADD(v, 0x4E); v = DPP_ADD(v, 0x141); v = DPP_ADD(v, 0x140);
    return v;
}
__device__ __forceinline__ float sigmoidf_(float x) { return __builtin_amdgcn_rcpf(1.f + __expf(-x)); }
__device__ __forceinline__ float siluf_(float x) { return x * __builtin_amdgcn_rcpf(1.f + __expf(-x)); }
__device__ __forceinline__ float tanhf_(float x) { return 1.f - 2.f * __builtin_amdgcn_rcpf(1.f + __expf(2.f * x)); }
__device__ __forceinline__ int cond_of_row(int m) { return m < M_P ? 0 : 1 + ((m - M_P) >> 11); }
struct RowSq { const float* p; int n; };
__device__ __forceinline__ float rowsq_wave(RowSq r, int m, int lane) { const float v = lane < r.n ? r.p[(size_t)lane * M + m] : 0.f; return wave_sum(v); }
__device__ __forceinline__ float rowsq_seq(RowSq r, int m) { float s = 0.f; for (int i = 0; i < r.n; ++i) s += r.p[(size_t)i * M + m]; return s; }

__device__ __forceinline__ int opaque_tid() { int t = threadIdx.x; asm volatile("" : "+v"(t)); return t; }

#define XB_TMO      128
#define XB_XCNT(j)  (256  + 64 * (j))
#define XB_XSUB(j)  (1280 + 64 * (j))
#define XB_XGEN(j)  (2304 + 64 * (j))
#define XB_TOP      3328
#define XB_TOPGEN   3392
#define XCD_BAR_WORDS 3456
#define XB_SPIN_CAP (1u << 20)

__device__ __forceinline__ unsigned xb_ld(unsigned* p)              { return __hip_atomic_load(p, __ATOMIC_RELAXED, __HIP_MEMORY_SCOPE_AGENT); }
__device__ __forceinline__ unsigned xb_add(unsigned* p, unsigned v) { return __hip_atomic_fetch_add(p, v, __ATOMIC_RELAXED, __HIP_MEMORY_SCOPE_AGENT); }
__device__ __forceinline__ unsigned xb_xcc_id() { return (unsigned)__builtin_amdgcn_s_getreg((3 << 11) | 20) & 0xFu; }
#define XB_SPIN(cond, bar) do { unsigned _sp = 0; while (cond) { __builtin_amdgcn_s_sleep(1); \
    if ((++_sp & 255u) == 0u) { if (xb_ld(&(bar)[XB_TMO])) break; if (_sp > XB_SPIN_CAP) { atomicAdd(&(bar)[XB_TMO], 1u); break; } } } } while (0)

struct XcdBarrier { unsigned* bar; unsigned x; volatile LAS unsigned* st; };

__device__ __forceinline__ XcdBarrier xcd_barrier_post(unsigned* bar, volatile LAS unsigned* st) {
    XcdBarrier b; b.bar = bar; b.x = xb_xcc_id(); b.st = st;
    if (threadIdx.x == 0) (void)xb_add(&bar[XB_XCNT(b.x)], 1u);
    return b;
}
__device__ __forceinline__ void xcd_barrier_complete(unsigned* bar, unsigned x, unsigned& nloc, unsigned& nx) {
    const unsigned G = gridDim.x * gridDim.y * gridDim.z;
    unsigned sum, cnt, mine, sp = 0u;
    for (;;) {
        sum = 0u; cnt = 0u; mine = 0u;
#pragma unroll
        for (unsigned j = 0; j < 16; ++j) { const unsigned c = xb_ld(&bar[XB_XCNT(j)]); sum += c; cnt += (c > 0u) ? 1u : 0u; mine = (j == x) ? c : mine; }
        if (sum == G) break;
        __builtin_amdgcn_s_sleep(1);
        if ((++sp & 255u) == 0u) { if (xb_ld(&bar[XB_TMO])) break; if (sp > XB_SPIN_CAP) { atomicAdd(&bar[XB_TMO], 1u); break; } }
    }
    nloc = mine > 0u ? mine : 1u; nx = cnt > 0u ? cnt : 1u;
}
__device__ __forceinline__ void xcd_barrier(const XcdBarrier& b) {
    asm volatile("s_waitcnt vmcnt(0)" ::: "memory");
    __syncthreads();
    if (threadIdx.x == 0) {
        unsigned* bar = b.bar;
        __builtin_amdgcn_s_waitcnt(0);
        unsigned nloc = b.st[0], nx = b.st[1];
        if (nloc == 0u) { xcd_barrier_complete(bar, b.x, nloc, nx); b.st[0] = nloc; b.st[1] = nx; }
        const unsigned old = xb_add(&bar[XB_XSUB(b.x)], 1u);
        const unsigned gen = old / nloc;
        if (old + 1u == (gen + 1u) * nloc) {
            __builtin_amdgcn_fence(__ATOMIC_RELEASE, "agent");
            asm volatile("s_waitcnt vmcnt(0)" ::: "memory");
            const unsigned og = xb_add(&bar[XB_TOP], 1u);
            const unsigned tg = og / nx;
            if (og + 1u == (tg + 1u) * nx) xb_add(&bar[XB_TOPGEN], 1u);
            else XB_SPIN(xb_ld(&bar[XB_TOPGEN]) == tg, bar);
            __builtin_amdgcn_fence(__ATOMIC_ACQUIRE, "agent");
            xb_add(&bar[XB_XGEN(b.x)], 1u);
            asm volatile("s_waitcnt vmcnt(0)" ::: "memory");
        } else {
            XB_SPIN(xb_ld(&bar[XB_XGEN(b.x)]) == gen, bar);
            __builtin_amdgcn_fence(__ATOMIC_ACQUIRE, "agent");
            asm volatile("s_waitcnt vmcnt(0)" ::: "memory");
        }
    }
    __syncthreads();
}

namespace pg8 {
constexpr bool KALT = true;
constexpr int BM = 256, BK = 64, HALF = 128, HTB = HALF * BK * 2  , STAGE_BYTES = 8 * HTB, NXCD = 8, WGM = 8;

__host__ __device__ __forceinline__ int lds_byte(int r, int c) { const int st = (r >> 4) * 2 + (c >> 5), rr = r & 15, cc = c & 31, ob = rr * 64 + cc * 2; return st * 1024 + (ob ^ (((ob >> 9) & 1) << 5)); }
__host__ __device__ __forceinline__ void stage_rc(int b, int& R, int& C) { const int st = b / 1024, sb = b % 1024, swz = sb ^ (((sb >> 9) & 1) << 5); R = (st >> 1) * 16 + swz / 64; C = (st & 1) * 32 + (swz % 64) / 2; }

struct Unit { int pm, pn, sub, pnl, nt; const char* a; const char* b; };

struct TileOrder {
    int nM, nN, nwg, G, c;
    __device__ void init(int nM_, int nN_, int G_, int c_) { nM = nM_; nN = nN_; nwg = nM * nN; G = G_; c = c_; }
    __device__ bool next(int i, int& pm, int& pn) const {
        const long L = (long)i * G + c; if (L >= nwg) return false;
        int wgid = (int)L; { const int q = nwg / NXCD, r = nwg % NXCD, xcd = wgid % NXCD, off = wgid / NXCD; wgid = (xcd < r ? xcd * (q + 1) : r * (q + 1) + (xcd - r) * q) + off; }
        const int nig = WGM * nN, gid = wgid / nig, fm = gid * WGM, gsz = (nM - fm) < WGM ? (nM - fm) : WGM;
        pm = fm + ((wgid % nig) % gsz); pn = (wgid % nig) / gsz; return true;
    }
};

template <class Epi, class Prob, bool ALIGN_EPI, bool SP2>
__device__ __forceinline__ void gemm_phase(LAS unsigned char* lds, const Prob& P, const Epi& E) {
    const int tid = opaque_tid(), wid = __builtin_amdgcn_readfirstlane(tid >> 6), lane = tid & 63, wr = wid >> 2, wc = wid & 3, fr = lane & 15, fq = lane >> 4;
    const int K = P.K, nt = K / BK;
    TileOrder S; S.init(P.nM, P.nN, (int)gridDim.x, (int)blockIdx.x);
    unsigned voffA[2], voffB[2];
#pragma unroll
    for (int i = 0; i < 2; ++i) { int R, C; stage_rc(tid * 16 + i * 8192, R, C);
        voffA[i] = (unsigned)(R * P.lda + C) * 2u; voffB[i] = (unsigned)(R * P.ldb + C) * 2u; }
    const int kfwd = BK * 2;
    const size_t hstepA = (size_t)HALF * P.lda * 2, hstepB = (size_t)HALF * P.ldb * 2;
    const unsigned ldsw = (unsigned)wid * 1024u;
    const int aoff = lds_byte(wr * 64 + fr, fq * 8), boff = lds_byte(wc * 32 + fr, fq * 8);
#define PG8_SA(b, h) (((b) * 2 + (h)) * HTB)
#define PG8_SB(b, h) ((4 + (b) * 2 + (h)) * HTB)
#define PG8_STAGE(bufoff, gbase, voff) do { _Pragma("unroll") for (int _i = 0; _i < 2; ++_i) \
        __builtin_amdgcn_global_load_lds((const unsigned*)((const char*)(gbase) + (voff)[_i]), (LAS unsigned*)(lds + (bufoff) + ldsw + _i * 8192), 16, 0, 0); } while (0)
#define PG8_LDA(dst, b, h) do { _Pragma("unroll") for (int m = 0; m < 4; ++m) _Pragma("unroll") for (int k = 0; k < 2; ++k) dst[m][k] = *(const LAS bf16x8*)(lds + PG8_SA(b, h) + aoff + m * 2048 + k * 1024); } while (0)
#define PG8_LDB(dst, b, h) do { _Pragma("unroll") for (int n = 0; n < 2; ++n) _Pragma("unroll") for (int k = 0; k < 2; ++k) dst[n][k] = *(const LAS bf16x8*)(lds + PG8_SB(b, h) + boff + n * 2048 + k * 1024); } while (0)
#define PG8_MMA(ai, bj, At, Bt) do { __builtin_amdgcn_s_setprio(1); _Pragma("unroll") for (int m = 0; m < 4; ++m) _Pragma("unroll") for (int n = 0; n < 2; ++n) _Pragma("unroll") for (int k = 0; k < 2; ++k) \
        acc[ai][bj][m][n] = __builtin_amdgcn_mfma_f32_16x16x32_bf16(Bt[n][k], At[m][k], acc[ai][bj][m][n], 0, 0, 0); __builtin_amdgcn_s_setprio(0); } while (0)
#define PG8_WAIT_V(n) asm volatile("s_waitcnt vmcnt(" #n ")" ::: "memory")
#define PG8_WAIT_L(n) asm volatile("s_waitcnt lgkmcnt(" #n ")" ::: "memory")
#define PG8_BAR __builtin_amdgcn_s_barrier()
#define PG8_SCHED __builtin_amdgcn_sched_barrier(0)
    Unit cur, nxt; int ui = 0;
    if (!S.next(0, cur.pm, cur.pn)) return;
    P.locate(cur);
    int ntc = nt;
    if constexpr (Prob::VAR_NT) ntc = cur.nt;
    f32x4 acc[2][2][4][2];
#pragma unroll
    for (int a = 0; a < 2; ++a)
#pragma unroll
        for (int b = 0; b < 2; ++b)
#pragma unroll
            for (int m = 0; m < 4; ++m)
#pragma unroll
                for (int n = 0; n < 2; ++n) acc[a][b][m][n] = (f32x4){0.f, 0.f, 0.f, 0.f};
    bf16x8 At[4][2], B0[2][2], B1[2][2];
    const char* cA = cur.a; const char* cB = cur.b; int kstep = kfwd;
    if constexpr (SP2) {
        PG8_STAGE(PG8_SB(0, 0), cB, voffB); PG8_STAGE(PG8_SB(0, 1), cB + hstepB, voffB); PG8_STAGE(PG8_SA(0, 0), cA, voffA); PG8_STAGE(PG8_SA(0, 1), cA + hstepA, voffA);
        if (wr == 1) PG8_BAR;
        PG8_WAIT_V(2); PG8_BAR;
        PG8_STAGE(PG8_SB(1, 0), cB + kstep, voffB); PG8_STAGE(PG8_SA(1, 0), cA + kstep, voffA); PG8_STAGE(PG8_SB(1, 1), cB + hstepB + kstep, voffB);
        PG8_WAIT_V(6); PG8_BAR;
    } else {
        PG8_STAGE(PG8_SB(0, 0), cB, voffB); PG8_STAGE(PG8_SA(0, 0), cA, voffA); PG8_STAGE(PG8_SB(0, 1), cB + hstepB, voffB); PG8_STAGE(PG8_SA(0, 1), cA + hstepA, voffA);
        if (wr == 1) PG8_BAR;
        PG8_WAIT_V(4); PG8_BAR;
        PG8_STAGE(PG8_SB(1, 0), cB + kstep, voffB); PG8_STAGE(PG8_SA(1, 0), cA + kstep, voffA); PG8_STAGE(PG8_SB(1, 1), cB + hstepB + kstep, voffB);
        PG8_WAIT_V(6); PG8_BAR;
    }
    for (;;) {
        const bool has_next = S.next(ui + 1, nxt.pm, nxt.pn);
        if (has_next) P.locate(nxt);
        int ntn = ntc; if constexpr (Prob::VAR_NT) { if (has_next) ntn = nxt.nt; }
        const int nstep = KALT ? -kstep : kstep, noff = (KALT && nstep < 0) ? (ntn - 1) * kfwd : 0;
        const char* nA = has_next ? nxt.a + noff : cA; const char* nB = has_next ? nxt.b + noff : cB;
        const int nst = has_next ? nstep : kstep;
        for (int t = 0; t < ntc; t += 2) {
            const bool last = (t == ntc - 2);
            const char* a1 = cA + (t + 1) * kstep;
            const char* a2 = last ? nA : cA + (t + 2) * kstep; const char* b2 = last ? nB : cB + (t + 2) * kstep;
            const char* a3 = a2 + (last ? nst : kstep); const char* b3 = b2 + (last ? nst : kstep);
            if constexpr (SP2) {
            PG8_LDB(B0, 0, 0); PG8_LDB(B1, 0, 1); PG8_SCHED; PG8_LDA(At, 0, 0); PG8_STAGE(PG8_SA(1, 1), a1 + hstepA, voffA);
            PG8_WAIT_V(8); PG8_WAIT_L(0); PG8_BAR; PG8_MMA(0, 0, At, B0); PG8_MMA(0, 1, At, B1); PG8_BAR; PG8_SCHED;
            PG8_LDA(At, 0, 1); PG8_STAGE(PG8_SB(0, 0), b2, voffB); PG8_STAGE(PG8_SB(0, 1), b2 + hstepB, voffB); PG8_STAGE(PG8_SA(0, 0), a2, voffA);
            PG8_WAIT_V(8); PG8_WAIT_L(0); PG8_BAR; PG8_MMA(1, 0, At, B0); PG8_MMA(1, 1, At, B1); PG8_BAR; PG8_SCHED;
            PG8_LDB(B0, 1, 0); PG8_LDB(B1, 1, 1); PG8_SCHED; PG8_LDA(At, 1, 0); PG8_STAGE(PG8_SA(0, 1), a2 + hstepA, voffA);
            PG8_WAIT_V(8); PG8_WAIT_L(0); PG8_BAR; PG8_MMA(0, 0, At, B0); PG8_MMA(0, 1, At, B1); PG8_BAR; PG8_SCHED;
            PG8_LDA(At, 1, 1); PG8_STAGE(PG8_SB(1, 0), b3, voffB); PG8_STAGE(PG8_SB(1, 1), b3 + hstepB, voffB); PG8_STAGE(PG8_SA(1, 0), a3, voffA);
            PG8_WAIT_V(8); PG8_WAIT_L(0); PG8_BAR; PG8_MMA(1, 0, At, B0); PG8_MMA(1, 1, At, B1); PG8_BAR; PG8_SCHED;
            } else {
            PG8_LDB(B0, 0, 0); PG8_SCHED; PG8_LDA(At, 0, 0); PG8_STAGE(PG8_SA(1, 1), a1 + hstepA, voffA);
            PG8_WAIT_L(8); PG8_BAR; PG8_WAIT_L(0); PG8_MMA(0, 0, At, B0); PG8_BAR; PG8_SCHED;
            PG8_LDB(B1, 0, 1); PG8_STAGE(PG8_SB(0, 0), b2, voffB);
            PG8_BAR; PG8_WAIT_L(0); PG8_MMA(0, 1, At, B1); PG8_BAR;
            PG8_LDA(At, 0, 1); PG8_STAGE(PG8_SA(0, 0), a2, voffA);
            PG8_BAR; PG8_WAIT_L(0); PG8_MMA(1, 0, At, B0); PG8_BAR; PG8_SCHED;
            PG8_STAGE(PG8_SB(0, 1), b2 + hstepB, voffB);
            PG8_WAIT_V(6); PG8_BAR; PG8_MMA(1, 1, At, B1); PG8_BAR;
            PG8_LDB(B0, 1, 0); PG8_SCHED; PG8_LDA(At, 1, 0); PG8_STAGE(PG8_SA(0, 1), a2 + hstepA, voffA);
            PG8_WAIT_L(8); PG8_BAR; PG8_WAIT_L(0); PG8_MMA(0, 0, At, B0); PG8_BAR; PG8_SCHED;
            PG8_LDB(B1, 1, 1); PG8_STAGE(PG8_SB(1, 0), b3, voffB);
            PG8_BAR; PG8_WAIT_L(0); PG8_MMA(0, 1, At, B1); PG8_BAR;
            PG8_LDA(At, 1, 1); PG8_STAGE(PG8_SA(1, 0), a3, voffA);
            PG8_BAR; PG8_WAIT_L(0); PG8_MMA(1, 0, At, B0); PG8_BAR; PG8_SCHED;
            PG8_STAGE(PG8_SB(1, 1), b3 + hstepB, voffB);
            PG8_WAIT_V(6); PG8_BAR; PG8_MMA(1, 1, At, B1); PG8_BAR;
            }
        }
        if constexpr (ALIGN_EPI) { if (wr == 0) PG8_BAR; }
        E(acc, cur, wr, wc, fr, fq);
        if (!has_next) break;
#pragma unroll
        for (int a = 0; a < 2; ++a)
#pragma unroll
            for (int b = 0; b < 2; ++b)
#pragma unroll
                for (int m = 0; m < 4; ++m)
#pragma unroll
                    for (int n = 0; n < 2; ++n) acc[a][b][m][n] = (f32x4){0.f, 0.f, 0.f, 0.f};
        cur = nxt; cA = nA; cB = nB; kstep = nst; ntc = ntn; ++ui;
        if constexpr (ALIGN_EPI) { if (wr == 1) PG8_BAR; }
    }
    PG8_WAIT_V(0);
    if constexpr (!ALIGN_EPI) { if (wr == 0) PG8_BAR; }
    PG8_BAR;
#undef PG8_SA
#undef PG8_SB
#undef PG8_STAGE
#undef PG8_LDA
#undef PG8_LDB
#undef PG8_MMA
#undef PG8_WAIT_V
#undef PG8_WAIT_L
#undef PG8_BAR
#undef PG8_SCHED
}
}

struct ProbSimple {
    static constexpr bool VAR_NT = false;
    const bf16_t* A; const bf16_t* Bt; int lda, ldb, K, nM, nN;
    __device__ __forceinline__ void locate(pg8::Unit& u) const { u.sub = 0; u.pnl = u.pn;
        u.a = (const char*)A + (size_t)u.pm * 256 * lda * 2; u.b = (const char*)Bt + (size_t)u.pn * 256 * ldb * 2; }
};
struct ProbPool {
    static constexpr bool VAR_NT = false;
    const bf16_t* A; const bf16_t* Bt; int lda, ldb, K, nM, nN;
    __device__ __forceinline__ void locate(pg8::Unit& u) const { u.sub = 0; u.pnl = u.pn;
        u.a = (const char*)A + ((size_t)u.pm * 256 * lda + (size_t)(u.pn >> 1) * 512) * 2; u.b = (const char*)Bt + (size_t)u.pn * 256 * ldb * 2; }
};
struct ProbRwkv1 {
    static constexpr bool VAR_NT = false;
    const bf16_t* X6; const bf16_t* Wrkv; const bf16_t* Wl1; int lda, ldb, K, nM, nN;
    __device__ __forceinline__ void locate(pg8::Unit& u) const {
        int xi; const char* b;
        if (u.pn < 24) { u.sub = u.pn >> 3; u.pnl = u.pn & 7; xi = u.sub == 0 ? 0 : (u.sub == 1 ? 2 : 3); b = (const char*)Wrkv + (size_t)u.sub * SZ_SQ + (size_t)u.pnl * 256 * ldb * 2; }
        else { const int j = u.pn - 24; u.sub = 3 + j; u.pnl = 0; xi = j == 0 ? 1 : (j == 1 ? 4 : 5); b = (const char*)Wl1 + (size_t)j * 256 * ldb * 2; }
        u.a = (const char*)X6 + (size_t)xi * SZ_H + (size_t)u.pm * 256 * lda * 2; u.b = b; }
};
struct ProbRwkv2 {
    static constexpr bool VAR_NT = true;
    const bf16_t* L1; const bf16_t* Ww2; const bf16_t* Wa2; const bf16_t* Wg2; int lda, ldb, K, nM, nN;
    __device__ __forceinline__ void locate(pg8::Unit& u) const {
        const bf16_t* w;
        if (u.pn < 16) { u.sub = 0; u.pnl = u.pn; w = Ww2; } else if (u.pn < 32) { u.sub = 1; u.pnl = u.pn - 16; w = Wa2; } else { u.sub = 2; u.pnl = u.pn - 32; w = Wg2; }
        const int e = u.sub < 2 ? (u.pnl >> 3) : 0; u.nt = u.sub < 2 ? 2 : 4;
        u.a = (const char*)L1 + ((size_t)u.pm * 256 * lda + (size_t)u.sub * 256 + (size_t)e * 128) * 2; u.b = (const char*)w + (size_t)u.pnl * 256 * ldb * 2; }
};

#define EPI_ARGS const f32x4 (&acc)[2][2][4][2], const pg8::Unit& u, int wr, int wc, int fr, int fq
struct EpiResid {
    float* xf; bf16_t* xb; const float* gate; const float* cscale; float* rowsq; const float* xs_lo; const float* xs_hi; int mode;
    template <int MODE> __device__ __forceinline__ void run(EPI_ARGS) const {
        const int cond = u.pm < 16 ? 0 : 1 + ((u.pm - 16) >> 3);
        const int col0 = u.pn * 256 + wc * 32 + 4 * fq;
        const float* gp = gate + (size_t)cond * MODW + col0;
        f32x4 gv[2][2];
#pragma unroll
        for (int bj = 0; bj < 2; ++bj)
#pragma unroll
            for (int n = 0; n < 2; ++n) gv[bj][n] = *(const f32x4*)(gp + bj * 128 + n * 16);
        if (cscale) { f32x4 cs[2][2];
#pragma unroll
            for (int bj = 0; bj < 2; ++bj)
#pragma unroll
                for (int n = 0; n < 2; ++n) cs[bj][n] = *(const f32x4*)(cscale + col0 + bj * 128 + n * 16);
#pragma unroll
            for (int bj = 0; bj < 2; ++bj)
#pragma unroll
                for (int n = 0; n < 2; ++n) gv[bj][n] *= cs[bj][n]; }
#pragma unroll
        for (int ai = 0; ai < 2; ++ai) {
            f32x4 xo4[MODE == 0 ? 4 : 1][2][2]; u32x2 xo2[MODE == 0 ? 1 : 4][2][2];
#pragma unroll
            for (int m = 0; m < 4; ++m) {
                const int row = u.pm * 256 + ai * 128 + wr * 64 + m * 16 + fr;
#pragma unroll
                for (int bj = 0; bj < 2; ++bj)
#pragma unroll
                    for (int n = 0; n < 2; ++n) {
                        if constexpr (MODE == 0) xo4[m][bj][n] = *(const f32x4*)((u.pm < 16 ? xs_lo + (size_t)row * DM : xs_hi + (size_t)(row - M_P) * DM) + col0 + bj * 128 + n * 16);
                        else xo2[m][bj][n] = *(const u32x2*)(xb + (size_t)row * PK + col0 + bj * 128 + n * 16); } }
            __builtin_amdgcn_sched_barrier(0);
#pragma unroll
            for (int m = 0; m < 4; ++m) {
                const int row = u.pm * 256 + ai * 128 + wr * 64 + m * 16 + fr; float ss = 0.f;
                bf16_t* xbr = xb + (size_t)row * PK + col0;
#pragma unroll
                for (int bj = 0; bj < 2; ++bj)
#pragma unroll
                    for (int n = 0; n < 2; ++n) { f32x4 xv;
                        if constexpr (MODE == 0) xv = xo4[m][bj][n]; else xv = bf4_to_f32(xo2[m][bj][n]);
                        xv += gv[bj][n] * acc[ai][bj][m][n];
                        if constexpr (MODE == 2) *(f32x4*)(xf + (size_t)row * DM + col0 + bj * 128 + n * 16) = xv;
                        else { const u32x2 w = f32_to_bf4(xv); *(u32x2*)(xbr + bj * 128 + n * 16) = w; xv = bf4_to_f32(w); }
                        ss += (xv.x * xv.x + xv.y * xv.y) + (xv.z * xv.z + xv.w * xv.w); }
                ss += __shfl_xor(ss, 16); ss += __shfl_xor(ss, 32);
                if (fq == 0) rowsq[(size_t)(u.pn * 4 + wc) * M + row] = ss;
            }
        }
    }
    __device__ __forceinline__ void operator()(EPI_ARGS) const {
        if (mode == 0) run<0>(acc, u, wr, wc, fr, fq); else if (mode == 1) run<1>(acc, u, wr, wc, fr, fq); else run<2>(acc, u, wr, wc, fr, fq);
    }
};
struct EpiBf16 {
    bf16_t* out; int ldc;
    __device__ __forceinline__ void operator()(EPI_ARGS) const {
        const int col0 = u.pn * 256 + wc * 32 + 4 * fq;
#pragma unroll
        for (int ai = 0; ai < 2; ++ai)
#pragma unroll
            for (int m = 0; m < 4; ++m) {
                const int row = u.pm * 256 + ai * 128 + wr * 64 + m * 16 + fr; bf16_t* op = out + (size_t)row * ldc + col0;
#pragma unroll
                for (int bj = 0; bj < 2; ++bj)
#pragma unroll
                    for (int n = 0; n < 2; ++n) *(u32x2*)(op + bj * 128 + n * 16) = f32_to_bf4(acc[ai][bj][m][n]);
            }
    }
};

__device__ __forceinline__ float dpp_ror1(float x)  { return __builtin_bit_cast(float, __builtin_amdgcn_update_dpp(0, __builtin_bit_cast(int, x), 0x121, 0xF, 0xF, true)); }
__device__ __forceinline__ float dpp_ror15(float x) { return __builtin_bit_cast(float, __builtin_amdgcn_update_dpp(0, __builtin_bit_cast(int, x), 0x12F, 0xF, 0xF, true)); }
__device__ __forceinline__ float dpp_shr1_old(float old, float x) { return __builtin_bit_cast(float, __builtin_amdgcn_update_dpp(__builtin_bit_cast(int, old), __builtin_bit_cast(int, x), 0x111, 0xF, 0xF, false)); }
__device__ __forceinline__ float dpp_shl1_old(float old, float x) { return __builtin_bit_cast(float, __builtin_amdgcn_update_dpp(__builtin_bit_cast(int, old), __builtin_bit_cast(int, x), 0x101, 0xF, 0xF, false)); }
struct EpiUpConv {
    bf16_t* act; float* halo; const float* cw; const float* cb; LAS float* xch;
    __device__ __forceinline__ void operator()(EPI_ARGS) const {
        const int cl = 32 * wc + 4 * fq;
#pragma unroll
        for (int ai = 0; ai < 2; ++ai) { const int seg = 2 * ai + wr;
            if (fr == 0) {
#pragma unroll
                for (int bj = 0; bj < 2; ++bj)
#pragma unroll
                    for (int n = 0; n < 2; ++n) *(LAS f32x4*)(xch + ((((seg * 4 + wc) * 2 + 0) * 2 + bj) * 2 + n) * 16 + 4 * fq) = acc[ai][bj][0][n]; }
            if (fr == 15) {
#pragma unroll
                for (int bj = 0; bj < 2; ++bj)
#pragma unroll
                    for (int n = 0; n < 2; ++n) *(LAS f32x4*)(xch + ((((seg * 4 + wc) * 2 + 1) * 2 + bj) * 2 + n) * 16 + 4 * fq) = acc[ai][bj][3][n]; } }
        if (wr == 0 && fr < 2) {
#pragma unroll
            for (int bj = 0; bj < 2; ++bj)
#pragma unroll
                for (int n = 0; n < 2; ++n) *(f32x4*)(halo + ((size_t)u.pm * 4 + fr) * FF2 + u.pn * 256 + bj * 128 + cl + 16 * n) = acc[0][bj][0][n]; }
        if (wr == 1 && fr >= 14) {
#pragma unroll
            for (int bj = 0; bj < 2; ++bj)
#pragma unroll
                for (int n = 0; n < 2; ++n) *(f32x4*)(halo + ((size_t)u.pm * 4 + 2 + (fr - 14)) * FF2 + u.pn * 256 + bj * 128 + cl + 16 * n) = acc[1][bj][3][n]; }
        asm volatile("s_waitcnt lgkmcnt(0)" ::: "memory"); __builtin_amdgcn_s_barrier(); asm volatile("" ::: "memory");
#pragma unroll
        for (int n = 0; n < 2; ++n) {
            const int ch = u.pn * 128 + cl + 16 * n;
            f32x4 wg[3], wv[3];
#pragma unroll
            for (int j = 0; j < 3; ++j) { wg[j] = *(const f32x4*)(cw + (size_t)j * FF2 + ch); wv[j] = *(const f32x4*)(cw + (size_t)j * FF2 + FF + ch); }
            const f32x4 bg = *(const f32x4*)(cb + ch), bv = *(const f32x4*)(cb + FF + ch);
#pragma unroll
            for (int ai = 0; ai < 2; ++ai) { const int seg = 2 * ai + wr;
                f32x4 xp[2], xn[2];
#pragma unroll
                for (int bj = 0; bj < 2; ++bj) {
                    xp[bj] = seg > 0 ? *(const LAS f32x4*)(xch + (((((seg - 1) * 4 + wc) * 2 + 1) * 2 + bj) * 2 + n) * 16 + 4 * fq) : (f32x4){0.f, 0.f, 0.f, 0.f};
                    xn[bj] = seg < 3 ? *(const LAS f32x4*)(xch + (((((seg + 1) * 4 + wc) * 2 + 0) * 2 + bj) * 2 + n) * 16 + 4 * fq) : (f32x4){0.f, 0.f, 0.f, 0.f}; }
#pragma unroll
                for (int m = 0; m < 4; ++m) {
                    f32x4 uc[2];
#pragma unroll
                    for (int bj = 0; bj < 2; ++bj) {
                        const f32x4 cur = acc[ai][bj][m][n]; f32x4 pv, nx;
#pragma unroll
                        for (int e = 0; e < 4; ++e) {
                            const float oldp = m == 0 ? xp[bj][e] : dpp_ror1(acc[ai][bj][m == 0 ? 0 : m - 1][n][e]);
                            const float oldn = m == 3 ? xn[bj][e] : dpp_ror15(acc[ai][bj][m == 3 ? 3 : m + 1][n][e]);
                            pv[e] = dpp_shr1_old(oldp, cur[e]); nx[e] = dpp_shl1_old(oldn, cur[e]); }
                        const f32x4 w0 = bj == 0 ? wg[0] : wv[0], w1 = bj == 0 ? wg[1] : wv[1], w2 = bj == 0 ? wg[2] : wv[2], bb = bj == 0 ? bg : bv;
                        uc[bj] = w0 * pv + w1 * cur + w2 * nx + bb; }
                    f32x4 o;
#pragma unroll
                    for (int e = 0; e < 4; ++e) o[e] = siluf_(uc[0][e]) * uc[1][e];
                    const int row = u.pm * 256 + ai * 128 + wr * 64 + m * 16 + fr;
                    *(u32x2*)(act + (size_t)row * PF + ch) = f32_to_bf4(o); } }
        }
    }
};
struct EpiRwkv1 {
    bf16_t* rkv; bf16_t* l1;
    __device__ __forceinline__ void operator()(EPI_ARGS) const {
        const int cl = wc * 32 + 4 * fq; const int sub = u.sub;
        bf16_t* base; int ldc;
        if (sub < 3) { base = rkv + (size_t)sub * M * PK + u.pnl * 256 + cl; ldc = PK; } else { base = l1 + (sub - 3) * 256 + cl; ldc = PL1; }
#pragma unroll
        for (int ai = 0; ai < 2; ++ai)
#pragma unroll
            for (int m = 0; m < 4; ++m) {
                const int row = u.pm * 256 + ai * 128 + wr * 64 + m * 16 + fr; bf16_t* op = base + (size_t)row * ldc;
#pragma unroll
                for (int bj = 0; bj < 2; ++bj)
#pragma unroll
                    for (int n = 0; n < 2; ++n) { f32x4 v = acc[ai][bj][m][n];
                        if (sub == 3) { v.x = tanhf_(v.x); v.y = tanhf_(v.y); v.z = tanhf_(v.z); v.w = tanhf_(v.w); }
                        else if (sub == 5) { v.x = sigmoidf_(v.x); v.y = sigmoidf_(v.y); v.z = sigmoidf_(v.z); v.w = sigmoidf_(v.w); }
                        *(u32x2*)(op + bj * 128 + n * 16) = f32_to_bf4(v); }
            }
    }
};
struct EpiRwkv2 {
    float* dec; bf16_t* aa; bf16_t* g; const float* w0; const float* a0;
    __device__ __forceinline__ void operator()(EPI_ARGS) const {
        const int sub = u.sub; const int e = (sub < 2) ? (u.pnl >> 3) : 0; const int col0 = ((sub < 2) ? (u.pnl & 7) : u.pnl) * 256 + wc * 32 + 4 * fq;
        f32x4 bv[2][2];
#pragma unroll
        for (int bj = 0; bj < 2; ++bj)
#pragma unroll
            for (int n = 0; n < 2; ++n) bv[bj][n] = sub == 0 ? *(const f32x4*)(w0 + e * DM + col0 + bj * 128 + n * 16) : (sub == 1 ? *(const f32x4*)(a0 + e * DM + col0 + bj * 128 + n * 16) : (f32x4){0.f, 0.f, 0.f, 0.f});
#pragma unroll
        for (int ai = 0; ai < 2; ++ai)
#pragma unroll
            for (int m = 0; m < 4; ++m) {
                const int row = u.pm * 256 + ai * 128 + wr * 64 + m * 16 + fr; const size_t off = ((size_t)e * M + row) * PK + col0;
#pragma unroll
                for (int bj = 0; bj < 2; ++bj)
#pragma unroll
                    for (int n = 0; n < 2; ++n) { f32x4 v = acc[ai][bj][m][n] + bv[bj][n];
                        if (sub == 0) { v.x = __expf(-0.606531f * sigmoidf_(v.x)); v.y = __expf(-0.606531f * sigmoidf_(v.y)); v.z = __expf(-0.606531f * sigmoidf_(v.z)); v.w = __expf(-0.606531f * sigmoidf_(v.w));
                            *(f32x4*)(dec + off + bj * 128 + n * 16) = v; }
                        else if (sub == 1) { v.x = sigmoidf_(v.x); v.y = sigmoidf_(v.y); v.z = sigmoidf_(v.z); v.w = sigmoidf_(v.w); *(u32x2*)(aa + off + bj * 128 + n * 16) = f32_to_bf4(v); }
                        else *(u32x2*)(g + off + bj * 128 + n * 16) = f32_to_bf4(v); }
            }
    }
};

struct Args { const float* in[N_IN]; float* out; unsigned char* ws; int ph_lo, ph_hi; };

__device__ __forceinline__ void transpose_item(const float* src, int ld_src, int Kvalid, int k0, int n0, bf16_t* dst, int ld_dst, int drow0, int dcol0, LAS float* scr, int lane) {
#pragma unroll 8
    for (int i = 0; i < 32; ++i) { const int kk = 2 * i + (lane >> 5); scr[kk * 33 + (lane & 31)] = (k0 + kk < Kvalid) ? src[(size_t)(k0 + kk) * ld_src + n0 + (lane & 31)] : 0.f; }
    asm volatile("s_waitcnt lgkmcnt(0)" ::: "memory");
    const int c = lane & 7;
#pragma unroll
    for (int j = 0; j < 4; ++j) { const int n = (lane >> 3) + 8 * j; const LAS float* s = scr + (8 * c) * 33 + n;
        u32x4 o; o.x = pk2(s[0 * 33], s[1 * 33]); o.y = pk2(s[2 * 33], s[3 * 33]); o.z = pk2(s[4 * 33], s[5 * 33]); o.w = pk2(s[6 * 33], s[7 * 33]);
        if (k0 + 8 * c < Kvalid) *(u32x4*)(dst + (size_t)(drow0 + n) * ld_dst + dcol0 + k0 + 8 * c) = o; }
    asm volatile("s_waitcnt lgkmcnt(0)" ::: "memory");
}

__device__ __forceinline__ void transpose_item64(const float* src, int ld_src, int Kvalid, int k0, int n0, bf16_t* dst, int ld_dst, int drow0, int dcol0, LAS unsigned* scr, int lane) {
    const int n4 = lane & 15, kr = lane >> 4;
    const f32x4 z = {0.f, 0.f, 0.f, 0.f};
    f32x4 av[8], bv[8];
    if (k0 + 64 <= Kvalid) {
#pragma unroll
        for (int it = 0; it < 8; ++it) { const float* p = src + (size_t)(k0 + 8 * it + 2 * kr) * ld_src + n0 + 4 * n4; av[it] = *(const f32x4*)p; bv[it] = *(const f32x4*)(p + ld_src); }
    } else {
#pragma unroll
        for (int it = 0; it < 8; ++it) { const int k = k0 + 8 * it + 2 * kr; const float* p = src + (size_t)k * ld_src + n0 + 4 * n4;
            av[it] = (k < Kvalid) ? *(const f32x4*)p : z; bv[it] = (k + 1 < Kvalid) ? *(const f32x4*)(p + ld_src) : z; }
    }
    __builtin_amdgcn_sched_barrier(0);
#pragma unroll
    for (int it = 0; it < 8; ++it) {
#pragma unroll
        for (int j = 0; j < 4; ++j) scr[(4 * n4 + j) * 33 + 4 * it + kr] = pk2(av[it][j], bv[it][j]); }
    asm volatile("s_waitcnt lgkmcnt(0)" ::: "memory");
    const int c = lane & 7;
#pragma unroll
    for (int jj = 0; jj < 8; ++jj) { const int n = (lane >> 3) + 8 * jj; const LAS unsigned* s = scr + n * 33 + 4 * c;
        u32x4 o; o.x = s[0]; o.y = s[1]; o.z = s[2]; o.w = s[3];
        if (k0 + 8 * c < Kvalid) *(u32x4*)(dst + (size_t)(drow0 + n) * ld_dst + dcol0 + k0 + 8 * c) = o; }
    asm volatile("s_waitcnt lgkmcnt(0)" ::: "memory");
}

__device__ __forceinline__ void convert_weights(const Args& A, LAS unsigned char* lds, int set, int part, int gw, int NGW) {
    const int tid = opaque_tid(), lane = tid & 63, wave = tid >> 6;
    unsigned char* ws = A.ws;
    LAS float* scr = (LAS float*)(lds + wave * 16384);
    LAS unsigned* scu = (LAS unsigned*)(lds + wave * 16384);
    constexpr int NI_UPL = 32 * 176, NI_DNL = 88 * 32, NI_PL = 8 * 8, NI_SQ = 32 * 32, NI_L1 = 32 * 3, NI_G1 = 32 * 4, NI_L2 = 2 * 32, NI_G2 = 4 * 32, NI_Q = 32 * 48;
    const int l = set;
    const int nextra = (set == 0 || set == 3) ? 4 * NI_PL : (set == 1 ? 4 * NI_SQ + 4 * NI_L1 + NI_G1 + 4 * NI_L2 + NI_G2 : NI_Q + NI_SQ);
    const int lo = part == 2 ? NI_UPL + NI_DNL : 0, nitems = part == 1 ? NI_UPL + NI_DNL : NI_UPL + NI_DNL + nextra;
    for (int it = lo + gw; it < nitems; it += NGW) {
        int r = it;
        if (r < NI_UPL) { const int kb = r / 176, nb = r % 176, n0 = nb * 64;
            const int drow0 = n0 < FF ? (n0 >> 7) * 256 + (n0 & 127) : ((n0 - FF) >> 7) * 256 + 128 + ((n0 - FF) & 127);
            transpose_item64(A.in[I_UP] + (size_t)l * DM * FF2, FF2, DM, kb * 64, n0, (bf16_t*)(ws + WS_WUP + l * SZ_UP), PK, drow0, 0, scu, lane); continue; }
        r -= NI_UPL;
        if (r < NI_DNL) { const int kb = r / 32, nb = r % 32;
            transpose_item64(A.in[I_DOWN] + (size_t)l * FF * DM, DM, FF, kb * 64, nb * 64, (bf16_t*)(ws + WS_WDN + l * SZ_DN), PF, nb * 64, 0, scu, lane); continue; }
        r -= NI_DNL;
        if (set == 0 || set == 3) { const int sg = (set == 0 ? 0 : 4) + r / NI_PL; r %= NI_PL; const int kb = r / 8, nb = r % 8;
            transpose_item64(A.in[I_POOLW] + (size_t)sg * 512 * 512, 512, 512, kb * 64, nb * 64, (bf16_t*)(ws + WS_WPOOL) + (size_t)sg * 512 * PPW, PPW, nb * 64, 0, scu, lane); continue; }
        if (set == 1) {
            if (r < 4 * NI_SQ) { const int w = r / NI_SQ; r %= NI_SQ; const int kb = r / 32, nb = r % 32; const int idx = w == 0 ? I_WR : (w == 1 ? I_WK : (w == 2 ? I_WV : I_WO));
                transpose_item64(A.in[idx], DM, DM, kb * 64, nb * 64, (bf16_t*)(ws + WS_WR + w * SZ_SQ), PK, nb * 64, 0, scu, lane); continue; }
            r -= 4 * NI_SQ;
            if (r < 4 * NI_L1) { const int we = r / NI_L1; r %= NI_L1; const int which = we >> 1, e = we & 1, kb = r / 3, nb = r % 3;
                transpose_item(A.in[which ? I_A1 : I_W1] + (size_t)e * DM * 96, 96, DM, kb * 64, nb * 32, (bf16_t*)(ws + WS_WL1), PK, which * 256 + e * 128 + nb * 32, 0, scr, lane); continue; }
            r -= 4 * NI_L1;
            if (r < NI_G1) { const int kb = r / 4, nb = r % 4;
                transpose_item64(A.in[I_G1], 256, DM, kb * 64, nb * 64, (bf16_t*)(ws + WS_WL1), PK, 512 + nb * 64, 0, scu, lane); continue; }
            r -= NI_G1;
            if (r < 4 * NI_L2) { const int we = r / NI_L2; r %= NI_L2; const int which = we >> 1, e = we & 1, kb = r / 32, nb = r % 32;
                transpose_item64(A.in[which ? I_A2 : I_W2] + (size_t)e * 96 * DM, DM, 96, kb * 64, nb * 64, (bf16_t*)(ws + (which ? WS_WA2 : WS_WW2)), PW2, e * DM + nb * 64, 0, scu, lane); continue; }
            r -= 4 * NI_L2;
            { const int kb = r / 32, nb = r % 32;
                transpose_item64(A.in[I_G2], DM, 256, kb * 64, nb * 64, (bf16_t*)(ws + WS_WG2), PW2, nb * 64, 0, scu, lane); continue; }
        }
        if (r < NI_Q) { const int kb = r / 48, nb = r % 48;
            transpose_item64(A.in[I_QKV], 3072, DM, kb * 64, nb * 64, (bf16_t*)(ws + WS_WQKV), PK, nb * 64, 0, scu, lane); continue; }
        r -= NI_Q;
        { const int kb = r / 32, nb = r % 32;
            transpose_item64(A.in[I_AO], DM, DM, kb * 64, nb * 64, (bf16_t*)(ws + WS_WAO), PK, nb * 64, 0, scu, lane); }
    }
}

__device__ __forceinline__ void phase_prologue(const Args& A, LAS unsigned char* lds) {
    const int tid = opaque_tid(), lane = tid & 63, wave = tid >> 6, G = gridDim.x, bx = blockIdx.x;
    unsigned char* ws = A.ws;
    for (int rep_ = 0; rep_ < REP_ADA; ++rep_) {
        LAS float* sl = (LAS float*)lds;
        LAS float* red = (LAS float*)(lds + 73728);
        const float* cc = A.in[I_C]; const float* cctx = A.in[I_CCTX];
        for (int i = tid; i < NCOND * DM; i += NTHREADS) { const int r = i / DM, k = i % DM; const float c = r == 0 ? cctx[k] : cc[(r - 1) * DM + k]; sl[k * 9 + r] = siluf_(c); }
        __syncthreads();
        float* mod = (float*)(ws + WS_MOD);
        for (int item = bx; item < 4 * 192; item += G) {
            const int l = item / 192, n0 = (item % 192) * 64;
            const float* W = A.in[I_ADAW] + (size_t)l * DM * MODW + n0 + (lane & 15) * 4;
            const int kr = tid >> 4;
            f32x4 acc[9];
#pragma unroll
            for (int r = 0; r < 9; ++r) acc[r] = (f32x4){0.f, 0.f, 0.f, 0.f};
#pragma unroll 8
            for (int k = kr; k < DM; k += 32) { const f32x4 w = *(const f32x4*)(W + (size_t)k * MODW);
#pragma unroll
                for (int r = 0; r < 9; ++r) acc[r] += sl[k * 9 + r] * w; }
#pragma unroll
            for (int r = 0; r < 9; ++r)
#pragma unroll
                for (int j = 0; j < 4; ++j) { float v = acc[r][j]; v += __shfl_xor(v, 16); v += __shfl_xor(v, 32); acc[r][j] = v; }
            if (lane < 16) {
#pragma unroll
                for (int r = 0; r < 9; ++r) *(LAS f32x4*)(red + (wave * 9 + r) * 64 + lane * 4) = acc[r];
            }
            __syncthreads();
            for (int o = tid; o < 9 * 64; o += NTHREADS) { const int r = o >> 6, c = o & 63; float s = 0.f;
#pragma unroll
                for (int w = 0; w < 8; ++w) s += red[(w * 9 + r) * 64 + c];
                mod[((size_t)l * 9 + r) * MODW + n0 + c] = s + A.in[I_ADAB][l * MODW + n0 + c]; }
            __syncthreads();
        }
    }
    __syncthreads();
    for (int rep_ = 0; rep_ < REP_TR; ++rep_) {
        const int gw = bx * NWAVES + wave, NGW = G * NWAVES;
        convert_weights(A, lds, 0, 0, gw, NGW);
        convert_weights(A, lds, 1, 2, gw, NGW);
        float* rowsq0 = (float*)(ws + WS_RSQ);
        for (int m = gw; m < M; m += NGW) {
            const float* src = m < M_P ? A.in[I_XP] + (size_t)m * DM : A.in[I_XS] + (size_t)(m - M_P) * DM; float ss = 0.f;
#pragma unroll
            for (int j = 0; j < 8; ++j) { const f32x4 v = *(const f32x4*)(src + 4 * lane + 256 * j); ss += (v.x * v.x + v.y * v.y) + (v.z * v.z + v.w * v.w); }
            ss = wave_sum(ss);
            if (lane == 0) rowsq0[m] = ss;
        }
    }
    {
        const int gt = bx * NTHREADS + tid, NT = G * NTHREADS; const u32x4 z4 = {0u, 0u, 0u, 0u};
        constexpr int PCS = PK * 2 / 16;
        for (int i = gt; i < 4 * 32 * PCS; i += NT) { const int blk = i / (32 * PCS), r = (i / PCS) % 32, pc = i % PCS;
            *(u32x4*)(ws + WS_WL1 + (size_t)(blk * 128 + 96 + r) * PK * 2 + pc * 16) = z4; }
        for (int i = gt; i < 2 * 4096 * 4; i += NT) { const int row = i >> 2, pc = i & 3;
            *(u32x4*)(ws + WS_WW2 + ((size_t)row * PW2 + 96) * 2 + pc * 16) = z4; }
    }
    {
        constexpr int NV = 8 * 512 * 512 / 8;
        for (int i = bx * NTHREADS + tid; i < 2 * NV; i += G * NTHREADS) {
            const bool isv = i >= NV; const int j = isv ? i - NV : i;
            const float* s = A.in[isv ? I_CV : I_CK] + (size_t)j * 8; const f32x4 a = *(const f32x4*)s, b = *(const f32x4*)(s + 4);
            u32x4 o; o.x = pk2(a.x, a.y); o.y = pk2(a.z, a.w); o.z = pk2(b.x, b.y); o.w = pk2(b.z, b.w);
            *(u32x4*)((bf16_t*)(ws + (isv ? WS_CVB : WS_CKB)) + (size_t)j * 8) = o;
        }
    }
}

__device__ __forceinline__ void phase_normmod(const bf16_t* xb, RowSq rowsq, const float* gain, const float* mod_sh, const float* mod_sc, bf16_t* out) {
    const int tid_ = opaque_tid(), lane = tid_ & 63, gw = blockIdx.x * NWAVES + (tid_ >> 6), NGW = gridDim.x * NWAVES;
    const int rpw = ((M + NGW - 1) / NGW + 1) & ~1;
    const int m_lo = gw * rpw, m_hi = min(M, m_lo + rpw);
    int ccur = -1; f32x4 G[4][2], S1[4][2], S0[4][2];
    for (int m = m_lo; m < m_hi; m += 2) {
        const float p0 = lane < rowsq.n ? rowsq.p[(size_t)lane * M + m] : 0.f, p1 = lane < rowsq.n ? rowsq.p[(size_t)lane * M + m + 1] : 0.f;
        u32x4 xa[4], xc[4];
#pragma unroll
        for (int j = 0; j < 4; ++j) { xa[j] = *(const u32x4*)(xb + (size_t)m * PK + 8 * lane + 512 * j); xc[j] = *(const u32x4*)(xb + (size_t)(m + 1) * PK + 8 * lane + 512 * j); }
#pragma unroll
        for (int h = 0; h < 2; ++h) {
            const int mm = m + h, cond = cond_of_row(mm);
            if (cond != ccur) { ccur = cond;
#pragma unroll
                for (int j = 0; j < 4; ++j)
#pragma unroll
                    for (int u = 0; u < 2; ++u) { const int c = 8 * lane + 512 * j + 4 * u; G[j][u] = *(const f32x4*)(gain + c); S1[j][u] = 1.f + *(const f32x4*)(mod_sc + (size_t)cond * MODW + c); S0[j][u] = *(const f32x4*)(mod_sh + (size_t)cond * MODW + c); } }
            const float rstd = rsqrtf(wave_sum(h == 0 ? p0 : p1) * (1.f / DM) + NORM_EPS);
            bf16_t* o = out + (size_t)mm * PK;
#pragma unroll
            for (int j = 0; j < 4; ++j) { const u32x4 w = h == 0 ? xa[j] : xc[j];
                const f32x4 lo = bf4_to_f32((u32x2){w.x, w.y}), hi = bf4_to_f32((u32x2){w.z, w.w});
                const u32x2 a = f32_to_bf4((lo * rstd * G[j][0]) * S1[j][0] + S0[j][0]), b = f32_to_bf4((hi * rstd * G[j][1]) * S1[j][1] + S0[j][1]);
                *(u32x4*)(o + 8 * lane + 512 * j) = (u32x4){a.x, a.y, b.x, b.y}; }
        }
    }
}
__device__ __forceinline__ void rows_rstd(RowSq rowsq, int sb, int T, int tfirst, int NR, LAS float* rs, int tid) {
    const int i = tid >> 3, j = tid & 7, t = tfirst + i;
    const int tc = min(max(t, 0), T - 1), m = sb + tc;
    float s = 0.f;
    float pv[RSQ_PARTS / 8];
#pragma unroll
    for (int q = 0; q < RSQ_PARTS / 8; ++q) pv[q] = rowsq.p[(size_t)min(j + 8 * q, rowsq.n - 1) * M + m];
    __builtin_amdgcn_sched_barrier(0);
#pragma unroll
    for (int q = 0; q < RSQ_PARTS / 8; ++q) s += (j + 8 * q) < rowsq.n ? pv[q] : 0.f;
    s = DPP_ADD(s, 0xB1); s = DPP_ADD(s, 0x4E); s = DPP_ADD(s, 0x141);
    if (j == 0 && i < NR) rs[i] = rsqrtf(s * (1.f / DM) + NORM_EPS);
}

template <int GI, bool BF>
__device__ __forceinline__ void pool_item(const float* x_lo, const float* x_hi, const bf16_t* xb, RowSq rowsq, const float* gain, const float* mod_sh, const float* mod_sc, bf16_t* out, LAS float* tile, LAS float* rs, int chunk, int c) {
    constexpr int WIN = 2 << GI, LEFT = WIN >> 1, RIGHT = WIN - 1 - LEFT, R0 = 8 - LEFT, NRW = 32 + LEFT + RIGHT;
    const int m0 = chunk * 32;
    int sb, T; if (m0 < M_P) { sb = m0 & ~(T_P - 1); T = T_P; } else { sb = M_P + ((m0 - M_P) & ~(T_S - 1)); T = T_S; }
    const int t0 = m0 - sb, cond = cond_of_row(m0), col = GI * 512 + c;
    rows_rstd(rowsq, sb, T, t0 - 8, 48, rs, c);
    constexpr int NJ = (NRW + 3) / 4;
    const int c4 = (c & 127) * 4, rsub = c >> 7, col4 = GI * 512 + c4;
    const f32x4 g4 = *(const f32x4*)(gain + col4), s14 = 1.f + *(const f32x4*)(mod_sc + (size_t)cond * MODW + col4), s04 = *(const f32x4*)(mod_sh + (size_t)cond * MODW + col4);
    f32x4 xv[BF ? 1 : NJ]; u32x2 xh[BF ? NJ : 1];
#pragma unroll
    for (int j = 0; j < NJ; ++j) { const int i = rsub + 4 * j, t = t0 - LEFT + i, tc = min(max(t, 0), T - 1), m = sb + tc;
        if constexpr (BF) xh[j] = *(const u32x2*)(xb + (size_t)m * PK + col4);
        else xv[j] = *(const f32x4*)(m < M_P ? x_lo + (size_t)m * DM + col4 : x_hi + (size_t)(m - M_P) * DM + col4); }
    __syncthreads();
    const f32x4 zero4 = {0.f, 0.f, 0.f, 0.f};
#pragma unroll
    for (int j = 0; j < NJ; ++j) { const int i = rsub + 4 * j, t = t0 - LEFT + i;
        f32x4 xj; if constexpr (BF) xj = bf4_to_f32(xh[j]); else xj = xv[j];
        if (i < NRW) *(LAS f32x4*)(tile + (R0 + i) * 512 + c4) = (t >= 0 && t < T) ? xj * rs[R0 + i] * g4 * s14 + s04 : zero4; }
    __syncthreads();
    float s = 0.f;
#pragma unroll
    for (int j = 0; j < WIN; ++j) s += tile[(R0 + j) * 512 + c];
#pragma unroll 4
    for (int i = 0; i < 32; ++i) { const int t = t0 + i, lo = max(t - LEFT, 0), hi = min(t + RIGHT + 1, T);
        const float o = s * __builtin_amdgcn_rcpf((float)(hi - lo)) - tile[(8 + i) * 512 + c];
        out[(size_t)(sb + t) * PK + col] = (bf16_t)f2bf(o);
        if (i < 31) s += tile[(8 + i + RIGHT + 1) * 512 + c] - tile[(8 + i - LEFT) * 512 + c]; }
    __syncthreads();
}
__device__ __forceinline__ void phase_pool_elem(const float* x_lo, const float* x_hi, const bf16_t* xb, RowSq rowsq, const float* gain, const float* mod_sh, const float* mod_sc, bf16_t* out, LAS unsigned char* lds) {
    LAS float* tile = (LAS float*)lds;
    LAS float* rs = (LAS float*)(lds + 48 * 512 * 4);
    const int c = opaque_tid();
    const int NI = (M / 32) * 4, G = gridDim.x; const bool xl = (G & 7) == 0 && (NI % G) == 0;
    const int nrnd = (NI + G - 1) / G;
    for (int rnd = 0; rnd < nrnd; ++rnd) {
        int item = (int)blockIdx.x + rnd * G; if (item >= NI) break;
        if (xl) { const int x = blockIdx.x & 7, j = blockIdx.x >> 3, per = NI / 8, wpx = G / 8; item = x * per + rnd * wpx + j; }
        const int chunk = item >> 2, gi = item & 3;
        if (xb) {
            if (gi == 0) pool_item<0, true>(x_lo, x_hi, xb, rowsq, gain, mod_sh, mod_sc, out, tile, rs, chunk, c);
            else if (gi == 1) pool_item<1, true>(x_lo, x_hi, xb, rowsq, gain, mod_sh, mod_sc, out, tile, rs, chunk, c);
            else if (gi == 2) pool_item<2, true>(x_lo, x_hi, xb, rowsq, gain, mod_sh, mod_sc, out, tile, rs, chunk, c);
            else pool_item<3, true>(x_lo, x_hi, xb, rowsq, gain, mod_sh, mod_sc, out, tile, rs, chunk, c);
        } else {
            if (gi == 0) pool_item<0, false>(x_lo, x_hi, xb, rowsq, gain, mod_sh, mod_sc, out, tile, rs, chunk, c);
            else if (gi == 1) pool_item<1, false>(x_lo, x_hi, xb, rowsq, gain, mod_sh, mod_sc, out, tile, rs, chunk, c);
            else if (gi == 2) pool_item<2, false>(x_lo, x_hi, xb, rowsq, gain, mod_sh, mod_sc, out, tile, rs, chunk, c);
            else pool_item<3, false>(x_lo, x_hi, xb, rowsq, gain, mod_sh, mod_sc, out, tile, rs, chunk, c);
        }
    }
}

__device__ __forceinline__ void phase_conv_fix(const float* halo, const float* cw, const float* cb, bf16_t* act) {
    const int tid = opaque_tid();
    for (int i = blockIdx.x * NTHREADS + tid; i < 56 * (FF / 4); i += gridDim.x * NTHREADS) {
        const int bd = i / (FF / 4), c = (i % (FF / 4)) * 4, tA = 16 + 8 * (bd / 7) + (bd % 7), tB = tA + 1;
        const int ug = (c >> 7) * 256 + (c & 127);
        f32x4 wg[3], wv[3];
#pragma unroll
        for (int j = 0; j < 3; ++j) { wg[j] = *(const f32x4*)(cw + (size_t)j * FF2 + c); wv[j] = *(const f32x4*)(cw + (size_t)j * FF2 + FF + c); }
        const f32x4 bg = *(const f32x4*)(cb + c), bv = *(const f32x4*)(cb + FF + c);
        const float* hA = halo + (size_t)tA * 4 * FF2 + ug; const float* hB = halo + (size_t)tB * 4 * FF2 + ug;
        const f32x4 g254 = *(const f32x4*)(hA + 2 * FF2), g255 = *(const f32x4*)(hA + 3 * FF2), g0 = *(const f32x4*)(hB), g1 = *(const f32x4*)(hB + FF2);
        const f32x4 v254 = *(const f32x4*)(hA + 2 * FF2 + 128), v255 = *(const f32x4*)(hA + 3 * FF2 + 128), v0 = *(const f32x4*)(hB + 128), v1 = *(const f32x4*)(hB + FF2 + 128);
        const f32x4 uga = wg[0] * g254 + wg[1] * g255 + wg[2] * g0 + bg, uva = wv[0] * v254 + wv[1] * v255 + wv[2] * v0 + bv;
        const f32x4 ugb = wg[0] * g255 + wg[1] * g0 + wg[2] * g1 + bg, uvb = wv[0] * v255 + wv[1] * v0 + wv[2] * v1 + bv;
        f32x4 oa, ob;
#pragma unroll
        for (int e2 = 0; e2 < 4; ++e2) { oa[e2] = siluf_(uga[e2]) * uva[e2]; ob[e2] = siluf_(ugb[e2]) * uvb[e2]; }
        *(u32x2*)(act + ((size_t)tA * 256 + 255) * PF + c) = f32_to_bf4(oa);
        *(u32x2*)(act + ((size_t)tB * 256) * PF + c) = f32_to_bf4(ob);
    }
}

__device__ __forceinline__ void phase_rwkv_shift(const bf16_t* xb, RowSq rowsq, const float* gain, const float* mod_sh, const float* mod_sc, const float* mu, bf16_t* X6, LAS unsigned char* lds) {
    LAS float* rs = (LAS float*)lds;
    const int tid = opaque_tid(), c = 4 * tid;
    for (int item = blockIdx.x; item < M / 16; item += gridDim.x) {
        const int m0 = item * 16; int sb, T; if (m0 < M_P) { sb = m0 & ~(T_P - 1); T = T_P; } else { sb = M_P + ((m0 - M_P) & ~(T_S - 1)); T = T_S; }
        const int t0 = m0 - sb, cond = cond_of_row(m0);
        __syncthreads();
        rows_rstd(rowsq, sb, T, t0 - 1, 18, rs, tid);
        f32x4 xv[18];
#pragma unroll
        for (int i = 0; i < 18; ++i) { const int t = t0 - 1 + i, tc = min(max(t, 0), T - 1); xv[i] = bf4_to_f32(*(const u32x2*)(xb + (size_t)(sb + tc) * PK + c)); }
        const f32x4 g = *(const f32x4*)(gain + c), s1 = 1.f + *(const f32x4*)(mod_sc + (size_t)cond * MODW + c), s0 = *(const f32x4*)(mod_sh + (size_t)cond * MODW + c);
        f32x4 muv[6];
#pragma unroll
        for (int i = 0; i < 6; ++i) muv[i] = *(const f32x4*)(mu + i * DM + c);
        __syncthreads();
        const f32x4 zero = {0.f, 0.f, 0.f, 0.f};
#pragma unroll
        for (int i = 0; i < 18; ++i) { const int t = t0 - 1 + i; xv[i] = (t >= 0 && t < T) ? (xv[i] * rs[i] * g) * s1 + s0 : zero; }
#pragma unroll
        for (int i = 0; i < 16; ++i) { const f32x4 hc = xv[i + 1], xx = 0.5f * (xv[i] + xv[i + 2]) - hc; const size_t off = (size_t)(m0 + i) * PK + c;
#pragma unroll
            for (int k = 0; k < 6; ++k) *(u32x2*)(X6 + (size_t)k * M * PK + off) = f32_to_bf4(hc + xx * muv[k]); }
    }
}

__device__ __forceinline__ float dpp_ror4(float x)  { return __builtin_bit_cast(float, __builtin_amdgcn_update_dpp(0, __builtin_bit_cast(int, x), 0x124, 0xF, 0xF, true)); }
__device__ __forceinline__ float dpp_ror12(float x) { return __builtin_bit_cast(float, __builtin_amdgcn_update_dpp(0, __builtin_bit_cast(int, x), 0x12C, 0xF, 0xF, true)); }
__device__ __forceinline__ void phase_qk_norm_rope(bf16_t* QKV, const float* qn, const float* kn, float* out_ck, float* out_cv, LAS unsigned char* lds) {
    const int tid = opaque_tid(), lane = tid & 63, gw = blockIdx.x * NWAVES + (tid >> 6), NGW = gridDim.x * NWAVES;
    LAS f32x2* tab = (LAS f32x2*)lds;
    for (int o = tid; o < 64 * 32; o += NTHREADS) { const int pos = o >> 5, i = o & 31; float sn, cs; sincosf((float)pos * exp2f(-(float)i * (13.287712379549449f / 32.f)), &sn, &cs); tab[o] = (f32x2){cs, sn}; }
    __syncthreads();
    const int li = lane & 15, g4 = lane >> 4, axis = li >> 3, ib = (li & 3) * 8;
    const bool hi_half = (li & 4) != 0;
    f32x4 qw[2], kw[2];
#pragma unroll
    for (int u = 0; u < 2; ++u) { qw[u] = *(const f32x4*)(qn + 8 * li + 4 * u); kw[u] = *(const f32x4*)(kn + 8 * li + 4 * u); }
    for (int m = gw; m < M; m += NGW) {
        const bool samp = m >= M_P; bf16_t* row = QKV + (size_t)m * PQ + 8 * lane;
        u32x4 ch[6];
#pragma unroll
        for (int j = 0; j < 6; ++j) ch[j] = *(const u32x4*)(row + 512 * j);
        f32x2 cs8[8];
        if (samp) { const int t = (m - M_P) & (T_S - 1), pos = axis == 0 ? (t >> 6) : (t & 63);
#pragma unroll
            for (int e2 = 0; e2 < 8; ++e2) cs8[e2] = tab[pos * 32 + ib + e2]; }
#pragma unroll
        for (int j = 0; j < 5; ++j) {
            float xv[8];
#pragma unroll
            for (int p = 0; p < 4; ++p) { xv[2 * p] = bflo(ch[j][p]); xv[2 * p + 1] = bfhi(ch[j][p]); }
            float ss = 0.f;
#pragma unroll
            for (int e2 = 0; e2 < 8; ++e2) ss += xv[e2] * xv[e2];
            const float rstd = rsqrtf(row16_sum(ss) * (1.f / 128.f) + NORM_EPS);
#pragma unroll
            for (int e2 = 0; e2 < 8; ++e2) xv[e2] *= rstd * (j < 4 ? qw[e2 >> 2][e2 & 3] : kw[e2 >> 2][e2 & 3]);
            if (!samp && j == 4) { float* ck = out_ck + (size_t)m * 512 + g4 * 128 + 8 * li;
                *(f32x4*)ck = (f32x4){xv[0], xv[1], xv[2], xv[3]}; *(f32x4*)(ck + 4) = (f32x4){xv[4], xv[5], xv[6], xv[7]}; }
            if (samp) {
#pragma unroll
                for (int e2 = 0; e2 < 8; ++e2) { const float pa = __shfl_xor(xv[e2], 4);
                    xv[e2] = xv[e2] * cs8[e2].x + (hi_half ? pa : -pa) * cs8[e2].y; } }
            u32x4 w; w.x = pk2(xv[0], xv[1]); w.y = pk2(xv[2], xv[3]); w.z = pk2(xv[4], xv[5]); w.w = pk2(xv[6], xv[7]);
            *(u32x4*)(row + 512 * j) = w;
        }
        if (!samp) { float* cv = out_cv + (size_t)m * 512 + g4 * 128 + 8 * li;
            *(f32x4*)cv = (f32x4){bflo(ch[5].x), bfhi(ch[5].x), bflo(ch[5].y), bfhi(ch[5].y)}; *(f32x4*)(cv + 4) = (f32x4){bflo(ch[5].z), bfhi(ch[5].z), bflo(ch[5].w), bfhi(ch[5].w)}; }
    }
}

__device__ __forceinline__ float dpp_xor1(float x) { return __builtin_bit_cast(float, __builtin_amdgcn_update_dpp(0, __builtin_bit_cast(int, x), 0xB1, 0xF, 0xF, true)); }
__device__ __forceinline__ float dpp_xor2(float x) { return __builtin_bit_cast(float, __builtin_amdgcn_update_dpp(0, __builtin_bit_cast(int, x), 0x4E, 0xF, 0xF, true)); }

struct ScanArgs { const bf16_t* R; const bf16_t* Kb; const bf16_t* V; const float* DEC; const bf16_t* AA; const bf16_t* Gt; bf16_t* OFB; bf16_t* Y;
                  const float* state_in; float* state_out; const float* k_k; const float* k_a; const float* r_k; const float* ln_w; const float* ln_b; };

typedef __bf16 bf16x2_t_ __attribute__((ext_vector_type(2)));
__device__ __forceinline__ unsigned cvt_pk_bf16_(float lo, float hi) { const f32x2 v = {lo, hi}; const bf16x2_t_ b = __builtin_convertvector(v, bf16x2_t_); return __builtin_bit_cast(unsigned, b); }
__device__ __forceinline__ bf16x8 mk8(unsigned x, unsigned y, unsigned z, unsigned w) { u32x4 t = {x, y, z, w}; return __builtin_bit_cast(bf16x8, t); }
__device__ __forceinline__ bf16x8 mk4(u32x2 x) { return mk8(x.x, x.y, 0u, 0u); }
__device__ __forceinline__ bf16x8 mk44(u32x2 x, u32x2 y) { return mk8(x.x, x.y, y.x, y.y); }
__device__ __forceinline__ f32x4 mma(bf16x8 a, bf16x8 b, f32x4 c) { return __builtin_amdgcn_mfma_f32_16x16x32_bf16(a, b, c, 0, 0, 0); }
__device__ __forceinline__ f32x4 mma16(u32x2 a, u32x2 b, f32x4 c) { return __builtin_amdgcn_mfma_f32_16x16x16bf16_1k(__builtin_bit_cast(s16x4, a), __builtin_bit_cast(s16x4, b), c, 0, 0, 0); }
__device__ __forceinline__ void st_to_bf16(const f32x4 (&St)[4], bf16x8& s0, bf16x8& s1) {
    s0 = mk8(cvt_pk_bf16_(St[0].x, St[0].y), cvt_pk_bf16_(St[0].z, St[0].w), cvt_pk_bf16_(St[1].x, St[1].y), cvt_pk_bf16_(St[1].z, St[1].w));
    s1 = mk8(cvt_pk_bf16_(St[2].x, St[2].y), cvt_pk_bf16_(St[2].z, St[2].w), cvt_pk_bf16_(St[3].x, St[3].y), cvt_pk_bf16_(St[3].z, St[3].w));
}
constexpr int TKP = 144;
constexpr int CH_WRAW = 0, CH_AT = 4096, CH_RT = CH_AT + 16 * TKP, CH_BT = CH_RT + 16 * TKP, CH_KT = CH_BT + 16 * TKP;
constexpr int KSP = 36;
constexpr int CH_BHK = CH_KT + 16 * TKP, CH_KHK = CH_BHK + 64 * KSP, CH_VT = CH_KHK + 64 * KSP, CH_GC = CH_VT + 64 * KSP, CH_GA = CH_GC + 256, CH_DIAG = CH_GA + 2048, CH_BYTES = ((CH_DIAG + 512 + 511) / 512) * 512;
static_assert(4 * CH_BYTES <= 131072 && CH_GC % 16 == 0 && CH_GA % 16 == 0 && CH_DIAG % 16 == 0, "scan LDS");
__device__ __forceinline__ u32x2 lds_ld2(const LAS unsigned char* p) { const LAS unsigned* q = (const LAS unsigned*)p; return (u32x2){q[0], q[1]}; }
#define SCAN_BAR() do { asm volatile("s_waitcnt lgkmcnt(0)" ::: "memory"); __builtin_amdgcn_s_barrier(); asm volatile("" ::: "memory"); } while (0)

__device__ __forceinline__ void phase_scan(const ScanArgs& S, LAS unsigned char* lds) {
    const int tid = opaque_tid(), dir = tid >> 8, lt = tid & 255, wv = lt >> 6, lane = tid & 63, i16 = lane & 15, v = i16 + 16 * wv, q = lane >> 4;
    const int ps = lt >> 4, kg = lt & 15;
    const int swv = __builtin_amdgcn_readfirstlane(wv);
    for (int i = tid; i < 4 * 12 * 64; i += NTHREADS) *(LAS float*)(lds + (i / 768) * CH_BYTES + CH_WRAW + (i % 768) * 4) = 1.f;
    __syncthreads();
    for (int it = blockIdx.x; it < 256 + 512; it += gridDim.x) {
        const bool samp = it < 256; int b, h, T, row0;
        if (samp) { b = it >> 5; h = it & 31; T = T_S; row0 = M_P + b * T_S; } else { const int j = it - 256; b = j >> 5; h = j & 31; T = T_P; row0 = b * T_P; }
        f32x4 St[4];
        if (samp) { const float* sp = S.state_in + ((size_t)((b * 2 + dir) * 32 + h)) * 4096 + v * 64 + 4 * q;
#pragma unroll
            for (int kt = 0; kt < 4; ++kt) St[kt] = *(const f32x4*)(sp + 16 * kt); }
        else {
#pragma unroll
            for (int kt = 0; kt < 4; ++kt) St[kt] = (f32x4){0.f, 0.f, 0.f, 0.f}; }
        bf16x8 sb0, sb1; st_to_bf16(St, sb0, sb1);
        const int hc = h * 64 + 4 * kg;
        const f32x4 kkw = *(const f32x4*)(S.k_k + hc), kaw = *(const f32x4*)(S.k_a + hc);
        const int nchunk = T / 16;
        struct PF { u32x2 r, k, v, a; f32x4 w; };
        const int sdir = __builtin_amdgcn_readfirstlane(dir);
        const char* pR = (const char*)S.R; const char* pK = (const char*)S.Kb; const char* pV = (const char*)S.V;
        const char* pA = (const char*)(S.AA + (size_t)sdir * M * PK); const char* pW = (const char*)(S.DEC + (size_t)sdir * M * PK);
        const int cstep = (sdir == 0 ? 16 : -16) * PK * 2;
        unsigned poff = (unsigned)(((row0 + (dir == 0 ? ps : T - 1 - ps)) * PK + hc) * 2);
        auto prefetch = [&](PF& p) {
            p.r = *(const u32x2*)(pR + poff); p.k = *(const u32x2*)(pK + poff); p.v = *(const u32x2*)(pV + poff);
            p.a = *(const u32x2*)(pA + poff); p.w = *(const f32x4*)(pW + 2u * poff); poff += (unsigned)cstep; };
        f32x4 gmask;
#pragma unroll
        for (int r = 0; r < 4; ++r) { const int j = 4 * q + r, t = i16; gmask[r] = (wv == 0 ? (q < (t >> 2)) : (wv == 1 ? (j < t) : (j <= t))) ? 1.f : 0.f; }
        PF pfA, pfB;
        prefetch(pfA); prefetch(pfB);
        char* pO = (char*)(S.OFB + (size_t)sdir * M * PK);
        const int rstep = (sdir == 0 ? 1 : -1) * PK * 2;
        unsigned ooff = (unsigned)(((row0 + (dir == 0 ? 4 * q : T - 1 - 4 * q)) * PK + h * 64 + v) * 2);
        auto do_chunk = [&](int c, PF& pf) {
            LAS unsigned char* B = lds + ((c & 1) * 2 + dir) * CH_BYTES;
            const f32x4 r4 = bf4_to_f32(pf.r), k4 = bf4_to_f32(pf.k), v4 = bf4_to_f32(pf.v), a4 = bf4_to_f32(pf.a), w4 = pf.w;
            const f32x4 kv = k4 * kkw; float ss = (kv.x * kv.x + kv.y * kv.y) + (kv.z * kv.z + kv.w * kv.w);
            ss = row16_sum(ss);
            const float inv = fminf(__builtin_amdgcn_rsqf(ss), 1e12f);
            const f32x4 kk = kv * inv, kd = k4 * (1.f + (a4 - 1.f) * kaw), bb = kk * a4;
            f32x4 inc = w4, exw;
            {
                const f32x4 one = {1.f, 1.f, 1.f, 1.f}; f32x4 t;
#pragma unroll
                for (int e = 0; e < 4; ++e) t[e] = __shfl_up(inc[e], 16);
                inc *= (lane >= 16) ? t : one;
#pragma unroll
                for (int e = 0; e < 4; ++e) t[e] = __shfl_up(inc[e], 32);
                inc *= (lane >= 32) ? t : one;
#pragma unroll
                for (int e = 0; e < 4; ++e) t[e] = __shfl_up(inc[e], 16);
                exw = (lane >= 16) ? t : one;
                if (lane >= 48) {
                    for (int d = swv + 1; d < 4; ++d) *(LAS f32x4*)(B + CH_WRAW + (d * 3 + wv) * 256 + 16 * kg) = inc; }
            }
#pragma unroll
            for (int e = 0; e < 4; ++e) *(LAS bf16_t*)(B + CH_VT + (4 * kg + e) * KSP + 2 * ps) = (bf16_t)((e < 2 ? pf.v.x : pf.v.y) >> (16 * (e & 1)));
            SCAN_BAR();
            if (c + 2 < nchunk) prefetch(pf);
            {
                f32x4 wt[3];
#pragma unroll
                for (int u = 0; u < 3; ++u) wt[u] = *(const LAS f32x4*)(B + CH_WRAW + (wv * 3 + u) * 256 + 16 * kg);
                const f32x4 gp = ((exw * wt[0]) * wt[1]) * wt[2];
                const f32x4 g = gp * w4;
                f32x4 ig; ig.x = __builtin_amdgcn_rcpf(g.x); ig.y = __builtin_amdgcn_rcpf(g.y); ig.z = __builtin_amdgcn_rcpf(g.z); ig.w = __builtin_amdgcn_rcpf(g.w);
                const f32x4 ah = -kk * gp, bh = bb * ig, kh = kd * ig, rh = r4 * g;
                *(LAS u32x2*)(B + CH_AT + ps * TKP + 8 * kg) = f32_to_bf4(ah);
                *(LAS u32x2*)(B + CH_RT + ps * TKP + 8 * kg) = f32_to_bf4(rh);
                const u32x2 bhb = f32_to_bf4(bh), khb = f32_to_bf4(kh);
                *(LAS u32x2*)(B + CH_BT + ps * TKP + 8 * kg) = bhb;
                *(LAS u32x2*)(B + CH_KT + ps * TKP + 8 * kg) = khb;
                LAS unsigned char* pb = B + CH_BHK + (4 * kg) * KSP + 2 * ps; LAS unsigned char* pkh = B + CH_KHK + (4 * kg) * KSP + 2 * ps;
                *(LAS bf16_t*)(pb) = (bf16_t)(bhb.x & 0xffffu); *(LAS bf16_t*)(pb + KSP) = (bf16_t)(bhb.x >> 16); *(LAS bf16_t*)(pb + 2 * KSP) = (bf16_t)(bhb.y & 0xffffu); *(LAS bf16_t*)(pb + 3 * KSP) = (bf16_t)(bhb.y >> 16);
                *(LAS bf16_t*)(pkh) = (bf16_t)(khb.x & 0xffffu); *(LAS bf16_t*)(pkh + KSP) = (bf16_t)(khb.x >> 16); *(LAS bf16_t*)(pkh + 2 * KSP) = (bf16_t)(khb.y & 0xffffu); *(LAS bf16_t*)(pkh + 3 * KSP) = (bf16_t)(khb.y >> 16);
                if (ps == 15) *(LAS f32x4*)(B + CH_GC + 16 * kg) = g;
            }
            SCAN_BAR();
            {
                const LAS unsigned char* X = B + ((wv & 1) ? CH_KT : CH_BT) + i16 * TKP + 16 * q; const LAS unsigned char* Y = B + ((wv >> 1) ? CH_RT : CH_AT) + i16 * TKP + 16 * q;
                f32x4 d = {0.f, 0.f, 0.f, 0.f};
                d = mma(*(const LAS bf16x8*)X, *(const LAS bf16x8*)Y, d);
                d = mma(*(const LAS bf16x8*)(X + 64), *(const LAS bf16x8*)(Y + 64), d);
                const int t = i16;
                if (wv == 0) {
                    LAS float* dg = (LAS float*)(B + CH_DIAG) + (q == (t >> 2) ? (q * 16 + (t & 3)) : 64 + lane);
#pragma unroll
                    for (int r = 0; r < 4; ++r) dg[q == (t >> 2) ? 4 * r : 0] = d[r]; }
                *(LAS u32x2*)(B + CH_GA + (wv * 64 + lane) * 8) = f32_to_bf4(d * gmask);
            }
            SCAN_BAR();
            {
                const LAS unsigned char* pa_ = B + CH_AT + i16 * TKP + 8 * q; const LAS unsigned char* pr_ = B + CH_RT + i16 * TKP + 8 * q;
                const bf16x8 zA0 = mk44(*(const LAS u32x2*)(pa_), *(const LAS u32x2*)(pa_ + 32)), zA1 = mk44(*(const LAS u32x2*)(pa_ + 64), *(const LAS u32x2*)(pa_ + 96));
                const bf16x8 rA0 = mk44(*(const LAS u32x2*)(pr_), *(const LAS u32x2*)(pr_ + 32)), rA1 = mk44(*(const LAS u32x2*)(pr_ + 64), *(const LAS u32x2*)(pr_ + 96));
                const f32x4 zero = {0.f, 0.f, 0.f, 0.f};
                f32x4 Z = mma(zA0, sb0, zero); Z = mma(zA1, sb1, Z);
                f32x4 O = mma(rA0, sb0, zero); O = mma(rA1, sb1, O);
                const u32x2 Bv = lds_ld2(B + CH_VT + v * KSP + 8 * q);
                const u32x2 gab = *(const LAS u32x2*)(B + CH_GA + (0 * 64 + lane) * 8), gka = *(const LAS u32x2*)(B + CH_GA + (1 * 64 + lane) * 8);
                const u32x2 gbr = *(const LAS u32x2*)(B + CH_GA + (2 * 64 + lane) * 8), gkr = *(const LAS u32x2*)(B + CH_GA + (3 * 64 + lane) * 8);
                Z = mma16(gka, Bv, Z);
                const f32x4 d0 = *(const LAS f32x4*)(B + CH_DIAG + (q * 4 + 0) * 16), d1 = *(const LAS f32x4*)(B + CH_DIAG + (q * 4 + 1) * 16), d2 = *(const LAS f32x4*)(B + CH_DIAG + (q * 4 + 2) * 16);
                f32x4 U = Z;
                U.y += d0.y * U.x; U.z += d0.z * U.x + d1.z * U.y; U.w += d0.w * U.x + d1.w * U.y + d2.w * U.z;
#pragma unroll
                for (int Q = 1; Q < 4; ++Q) {
                    U = mma16(gab, (u32x2){cvt_pk_bf16_(U.x, U.y), cvt_pk_bf16_(U.z, U.w)}, Z);
                    U.y += d0.y * U.x; U.z += d0.z * U.x + d1.z * U.y; U.w += d0.w * U.x + d1.w * U.y + d2.w * U.z;
                }
                const u32x2 Ub = {cvt_pk_bf16_(U.x, U.y), cvt_pk_bf16_(U.z, U.w)};
                O = mma16(gbr, Ub, O); O = mma16(gkr, Bv, O);
#pragma unroll
                for (int r = 0; r < 4; ++r) *(bf16_t*)(pO + (ooff + (unsigned)(r * rstep))) = (bf16_t)f2bf(O[r]);
                ooff += (unsigned)cstep;
#pragma unroll
                for (int kt = 0; kt < 4; ++kt) {
                    const u32x2 abh = lds_ld2(B + CH_BHK + (16 * kt + i16) * KSP + 8 * q), akh = lds_ld2(B + CH_KHK + (16 * kt + i16) * KSP + 8 * q);
                    f32x4 s = mma16(abh, Ub, St[kt]); s = mma16(akh, Bv, s);
                    St[kt] = s * *(const LAS f32x4*)(B + CH_GC + 4 * (16 * kt + 4 * q)); }
                st_to_bf16(St, sb0, sb1);
            }
        };
        for (int c = 0; c < nchunk; c += 2) { do_chunk(c, pfA); do_chunk(c + 1, pfB); }
        if (!samp) { float* sp = S.state_out + ((size_t)((b * 2 + dir) * 32 + h)) * 4096 + v * 64 + 4 * q;
#pragma unroll
            for (int kt = 0; kt < 4; ++kt) *(f32x4*)(sp + 16 * kt) = St[kt]; }
        asm volatile("s_waitcnt vmcnt(0)" ::: "memory");
        __syncthreads();
        {
            const int tk = tid >> 4, hc2 = h * 64 + 4 * (tid & 15);
            const f32x4 lw = *(const f32x4*)(S.ln_w + hc2), lb = *(const f32x4*)(S.ln_b + hc2), ka = *(const f32x4*)(S.k_a + hc2), rk = *(const f32x4*)(S.r_k + hc2);
            struct OS { u32x2 of, ob, r, k, v, af, ab, g; };
            auto os_load = [&](size_t off) { OS q; q.of = *(const u32x2*)(S.OFB + off); q.ob = *(const u32x2*)(S.OFB + (size_t)M * PK + off); q.r = *(const u32x2*)(S.R + off); q.k = *(const u32x2*)(S.Kb + off);
                q.v = *(const u32x2*)(S.V + off); q.af = *(const u32x2*)(S.AA + off); q.ab = *(const u32x2*)(S.AA + (size_t)M * PK + off); q.g = *(const u32x2*)(S.Gt + off); return q; };
            auto os_finish = [&](const OS& q, size_t off) {
                const f32x4 o = bf4_to_f32(q.of) + bf4_to_f32(q.ob);
                const float mean = row16_sum((o.x + o.y) + (o.z + o.w)) * (1.f / 64.f);
                const f32x4 d = o - mean;
                const float var = row16_sum((d.x * d.x + d.y * d.y) + (d.z * d.z + d.w * d.w)) * (1.f / 64.f);
                const f32x4 on = d * rsqrtf(var + 64e-5f) * lw + lb;
                const f32x4 r4 = bf4_to_f32(q.r), k4 = bf4_to_f32(q.k), v4 = bf4_to_f32(q.v);
                const f32x4 af = bf4_to_f32(q.af), ab = bf4_to_f32(q.ab), g4 = bf4_to_f32(q.g);
                const f32x4 kds = k4 * ((1.f + (af - 1.f) * ka) + (1.f + (ab - 1.f) * ka));
                const f32x4 pr4 = r4 * kds * rk;
                const float bon = row16_sum((pr4.x + pr4.y) + (pr4.z + pr4.w));
                *(u32x2*)(S.Y + off) = f32_to_bf4((on + bon * v4) * g4); };
            for (int t = tk; t < T; t += 64) {
                const size_t off0 = (size_t)(row0 + t) * PK + hc2, off1 = off0 + (size_t)32 * PK;
                const OS q0 = os_load(off0), q1 = os_load(off1);
                __builtin_amdgcn_sched_barrier(0);
                os_finish(q0, off0); os_finish(q1, off1); }
        }
        __syncthreads();
    }
}

namespace attn {
constexpr int D = 128, NW = 8, QBLK = 32, KVBLK = 64;
constexpr float SCALE = 0.088388347648318440f;
constexpr float THR = 8.f;
constexpr size_t SHM_V = KVBLK * D * 2, SHM_K = KVBLK * D * 2, SHM_ATTN = 2 * SHM_V + 2 * SHM_K + NW * 64 * 4;
#define KSWZ(row, colB) ((row) * 256 + ((colB) ^ (((row) & 7) << 4)))
#define SBAR() __builtin_amdgcn_sched_barrier(0)
__device__ __forceinline__ int crow(int r, int hi) { return (r & 3) + 8 * (r >> 2) + 4 * hi; }
__device__ __forceinline__ unsigned cvtpk(float lo, float hi) { unsigned r; asm volatile("v_cvt_pk_bf16_f32 %0, %1, %2" : "=v"(r) : "v"(lo), "v"(hi)); return r; }

__device__ __forceinline__ void partialSM(f32x16& p0, f32x16& p1, float& m_reg, float& mn, float& alpha) {
    constexpr float C = SCALE * 1.4426950408889634f;
    float pmax = p0[0];
#pragma unroll
    for (int r = 1; r < 16; ++r) pmax = fmaxf(pmax, p0[r]);
#pragma unroll
    for (int r = 0; r < 16; ++r) pmax = fmaxf(pmax, p1[r]);
    { auto rr = __builtin_amdgcn_permlane32_swap(__float_as_uint(pmax), __float_as_uint(pmax), false, false);
      pmax = fmaxf(__uint_as_float(rr[0]), __uint_as_float(rr[1])); }
    if (__builtin_expect(__all(pmax - m_reg <= THR / SCALE), 1)) { mn = m_reg; alpha = 1.f; }
    else { mn = fmaxf(m_reg, pmax); alpha = __builtin_amdgcn_exp2f((m_reg - mn) * C); m_reg = mn; }
    const float mnC = -mn * C;
#pragma unroll
    for (int r = 0; r < 16; ++r) p0[r] = fmaf(p0[r], C, mnC);
#pragma unroll
    for (int r = 0; r < 16; ++r) p1[r] = fmaf(p1[r], C, mnC);
#pragma unroll
    for (int r = 0; r < 16; ++r) p0[r] = __builtin_amdgcn_exp2f(p0[r]);
}
__device__ __forceinline__ void finishSM(f32x16& p0, f32x16& p1, float alpha, float& l_reg, bf16x8& pa0, bf16x8& pa1, bf16x8& pa2, bf16x8& pa3) {
#pragma unroll
    for (int r = 0; r < 16; ++r) p1[r] = __builtin_amdgcn_exp2f(p1[r]);
    float ps = 0;
#pragma unroll
    for (int r = 0; r < 16; ++r) ps += p0[r];
#pragma unroll
    for (int r = 0; r < 16; ++r) ps += p1[r];
    { auto rr = __builtin_amdgcn_permlane32_swap(__float_as_uint(ps), __float_as_uint(ps), false, false);
      ps = __uint_as_float(rr[0]) + __uint_as_float(rr[1]); }
    l_reg = l_reg * alpha + ps;
#define PK4(P, BASE, OUT) do { unsigned a0 = cvtpk(P[BASE + 0], P[BASE + 1]), a1 = cvtpk(P[BASE + 2], P[BASE + 3]);   \
    unsigned b0 = cvtpk(P[BASE + 4], P[BASE + 5]), b1 = cvtpk(P[BASE + 6], P[BASE + 7]);                              \
    auto r0 = __builtin_amdgcn_permlane32_swap(a0, b0, false, false); auto r1 = __builtin_amdgcn_permlane32_swap(a1, b1, false, false); \
    u32x4 w = {r0[0], r1[0], r0[1], r1[1]}; OUT = __builtin_bit_cast(bf16x8, w); } while (0)
    PK4(p0, 0, pa0); PK4(p0, 8, pa1); PK4(p1, 0, pa2); PK4(p1, 8, pa3);
#undef PK4
}
__device__ __forceinline__ void qkt(f32x16& p0, f32x16& p1, const LAS char* Ks, const bf16x8* qr, int r32, int hi) {
    p0 = f32x16{}; p1 = f32x16{};
#pragma unroll
    for (int d0 = 0; d0 < 8; ++d0) { const int cb = (d0 * 16 + hi * 8) * 2;
        const bf16x8 b0 = *(const LAS bf16x8*)(Ks + KSWZ(r32, cb));
        const bf16x8 b1 = *(const LAS bf16x8*)(Ks + KSWZ(32 + r32, cb));
        p0 = __builtin_amdgcn_mfma_f32_32x32x16_bf16(b0, qr[d0], p0, 0, 0, 0);
        p1 = __builtin_amdgcn_mfma_f32_32x32x16_bf16(b1, qr[d0], p1, 0, 0, 0); }
}
__device__ __forceinline__ void band_mask(f32x16& p0, f32x16& p1, int kt0, int qpos, int hi) {
#pragma unroll
    for (int r = 0; r < 16; ++r) { const int d0 = qpos - (kt0 + crow(r, hi)), d1 = d0 - 32;
        if (d0 > 128 || d0 < -128) p0[r] = -1e30f;
        if (d1 > 128 || d1 < -128) p1[r] = -1e30f; }
}
__device__ __forceinline__ int v_st(int k, int c) { const int kk = (k & ~0xC) | ((k & 4) << 1) | ((k & 8) >> 1); return ((kk >> 3) * 4 + (c >> 5)) * 512 + ((kk & 7) * 32 + (c & 31)) * 2; }
__device__ __forceinline__ int v_rd_base(int lane) { return ((lane & 3) << 3) | (((lane >> 2) & 3) << 6) | (((lane >> 4) & 1) << 5) | (((lane >> 5) & 1) << 8); }
constexpr int v_rd_off(int d0, int ks, int half) { return d0 * 512 + ks * 4096 + half * 2048; }
template <int OFF> __device__ __forceinline__ s16x4 tr_read(int vb) {
    s16x4 r; asm volatile("ds_read_b64_tr_b16 %0, %1 offset:%2" : "=&v"(r) : "v"(vb), "i"(OFF) : "memory"); return r;
}
template <int D0> __device__ __forceinline__ void pv_one(f32x16& od, int vb, bf16x8 pa0, bf16x8 pa1, bf16x8 pa2, bf16x8 pa3) {
    const s16x4 l0 = tr_read<v_rd_off(D0, 0, 0)>(vb), h0 = tr_read<v_rd_off(D0, 0, 1)>(vb), l1 = tr_read<v_rd_off(D0, 1, 0)>(vb), h1 = tr_read<v_rd_off(D0, 1, 1)>(vb);
    const s16x4 l2 = tr_read<v_rd_off(D0, 2, 0)>(vb), h2 = tr_read<v_rd_off(D0, 2, 1)>(vb), l3 = tr_read<v_rd_off(D0, 3, 0)>(vb), h3 = tr_read<v_rd_off(D0, 3, 1)>(vb);
    asm volatile("s_waitcnt lgkmcnt(0)" ::: "memory"); SBAR();
#define PK(L, H) (bf16x8){L[0], L[1], L[2], L[3], H[0], H[1], H[2], H[3]}
    od = __builtin_amdgcn_mfma_f32_32x32x16_bf16(pa0, PK(l0, h0), od, 0, 0, 0);
    od = __builtin_amdgcn_mfma_f32_32x32x16_bf16(pa1, PK(l1, h1), od, 0, 0, 0);
    od = __builtin_amdgcn_mfma_f32_32x32x16_bf16(pa2, PK(l2, h2), od, 0, 0, 0);
    od = __builtin_amdgcn_mfma_f32_32x32x16_bf16(pa3, PK(l3, h3), od, 0, 0, 0);
#undef PK
}
__device__ __forceinline__ void pv_d0(f32x16* o, int vb, bf16x8 pa0, bf16x8 pa1, bf16x8 pa2, bf16x8 pa3) {
    pv_one<0>(o[0], vb, pa0, pa1, pa2, pa3); pv_one<1>(o[1], vb, pa0, pa1, pa2, pa3); pv_one<2>(o[2], vb, pa0, pa1, pa2, pa3); pv_one<3>(o[3], vb, pa0, pa1, pa2, pa3);
}

struct UnitDesc {
    const bf16_t* q;
    const bf16_t* ctxK; const bf16_t* ctxV;
    const bf16_t* bandK; const bf16_t* bandV;
    bf16_t* o;
    int nctx, band_lo, nband, q0, masked, head0;
};

__device__ __forceinline__ void attn_unit(const UnitDesc& U, const float* sink, LAS char* lds) {
    const int tid = opaque_tid(), wid = tid >> 6, lane = tid & 63, r32 = lane & 31, hi = lane >> 5;
    LAS char* V_lds = lds; LAS char* K_lds = lds + 2 * SHM_V;
    LAS float* wsx = (LAS float*)(lds + 2 * SHM_V + 2 * SHM_K) + wid * 64; LAS float* li_l = wsx; LAS float* al_l = wsx + 32;
    float m_reg = -1e30f, l_reg = 0; f32x16 o[4] = {}; bf16x8 qr[8];
    const int head = U.head0 + (wid >> 2), qrow = 32 * (wid & 3) + r32, qpos = U.q0 + qrow;
    const bf16_t* Qw = U.q + (size_t)qrow * PQ + head * 128 + hi * 8;
#pragma unroll
    for (int d0 = 0; d0 < 8; ++d0) qr[d0] = *(const bf16x8*)(Qw + d0 * 16);
    const int sr = tid >> 4, sc = (tid & 15) * 8, vst0 = v_st(sr, sc), vst1 = v_st(32 + sr, sc);
    const int vb0 = (int)(unsigned)(uintptr_t)V_lds + v_rd_base(lane);
    bf16x8 s_vs0[2], s_vs1[2], s_ks0[2], s_ks1[2];
    const int NT = U.nctx + U.nband;
#define TSRC(j, kp, vp, ld) const bf16_t* kp; const bf16_t* vp; int ld; do { if ((j) < U.nctx) { kp = U.ctxK + (size_t)(j) * 64 * 512; vp = U.ctxV + (size_t)(j) * 64 * 512; ld = 512; } \
        else { const size_t _o = (size_t)(U.band_lo + ((j) - U.nctx) * 64) * PQ; kp = U.bandK + _o; vp = U.bandV + _o; ld = PQ; } } while (0)
#define SLOAD(i, j) do { TSRC(j, _kp, _vp, _ld); s_vs0[i] = *(const bf16x8*)(_vp + (size_t)sr * _ld + sc); s_vs1[i] = *(const bf16x8*)(_vp + (size_t)(32 + sr) * _ld + sc); \
        s_ks0[i] = *(const bf16x8*)(_kp + (size_t)sr * _ld + sc); s_ks1[i] = *(const bf16x8*)(_kp + (size_t)(32 + sr) * _ld + sc); } while (0)
#define SWRITE(b, i) do { *(LAS bf16x8*)(V_lds + (b) * SHM_V + vst0) = s_vs0[i]; *(LAS bf16x8*)(V_lds + (b) * SHM_V + vst1) = s_vs1[i]; const int kc = sc * 2; \
        *(LAS bf16x8*)(K_lds + (b) * SHM_K + KSWZ(sr, kc)) = s_ks0[i]; *(LAS bf16x8*)(K_lds + (b) * SHM_K + KSWZ(32 + sr, kc)) = s_ks1[i]; } while (0)
#define SWAIT() asm volatile("s_waitcnt vmcnt(4)" ::: "memory")
#define RESC(a) do { if (__any((a) < 1.f)) { if (hi == 0) al_l[r32] = (a); asm volatile("s_waitcnt lgkmcnt(0)" ::: "memory"); \
        _Pragma("unroll") for (int d = 0; d < 4; ++d) _Pragma("unroll") for (int r = 0; r < 16; ++r) o[d][r] *= al_l[crow(r, hi)]; } } while (0)
#define MASK(p0, p1, j) do { if (U.masked && (j) >= U.nctx) band_mask(p0, p1, U.band_lo + ((j) - U.nctx) * 64, qpos, hi); } while (0)
    f32x16 pA0, pA1, pB0, pB1; float mnA, mnB, alA, alB; bf16x8 pa0, pa1, pa2, pa3;
    constexpr int SE = 0, SO = 1;
    SLOAD(SE, 0); asm volatile("s_waitcnt vmcnt(0)" ::: "memory"); SWRITE(0, SE); __syncthreads();
    qkt(pA0, pA1, K_lds, qr, r32, hi); MASK(pA0, pA1, 0); partialSM(pA0, pA1, m_reg, mnA, alA);
    SLOAD(SO, 1); if (2 < NT) SLOAD(SE, 2);
    SWAIT(); SWRITE(1, SO); __syncthreads();
    for (int j = 1; j + 1 < NT; j += 2) {
        SBAR(); qkt(pB0, pB1, K_lds + SHM_K, qr, r32, hi); MASK(pB0, pB1, j);
        finishSM(pA0, pA1, alA, l_reg, pa0, pa1, pa2, pa3); SBAR();
        SLOAD(SO, j + 2); SBAR();
        pv_d0(o, vb0, pa0, pa1, pa2, pa3); partialSM(pB0, pB1, m_reg, mnB, alB);
        __syncthreads(); SWAIT(); SWRITE(0, SE);
        RESC(alB); __syncthreads();
        SBAR(); qkt(pA0, pA1, K_lds, qr, r32, hi); MASK(pA0, pA1, j + 1);
        finishSM(pB0, pB1, alB, l_reg, pa0, pa1, pa2, pa3); SBAR();
        if (j + 3 < NT) SLOAD(SE, j + 3); SBAR();
        pv_d0(o, vb0 + (int)SHM_V, pa0, pa1, pa2, pa3); partialSM(pA0, pA1, m_reg, mnA, alA);
        __syncthreads(); SWAIT(); SWRITE(1, SO);
        RESC(alA); __syncthreads();
    }
    SBAR(); qkt(pB0, pB1, K_lds + SHM_K, qr, r32, hi); MASK(pB0, pB1, NT - 1);
    finishSM(pA0, pA1, alA, l_reg, pa0, pa1, pa2, pa3); SBAR();
    pv_d0(o, vb0, pa0, pa1, pa2, pa3); partialSM(pB0, pB1, m_reg, mnB, alB);
    __syncthreads(); RESC(alB);
    finishSM(pB0, pB1, alB, l_reg, pa0, pa1, pa2, pa3); SBAR();
    pv_d0(o, vb0 + (int)SHM_V, pa0, pa1, pa2, pa3);
    l_reg += __builtin_amdgcn_exp2f(sink[head] * 1.4426950408889634f - m_reg * (SCALE * 1.4426950408889634f));
    if (hi == 0) li_l[r32] = l_reg; asm volatile("s_waitcnt lgkmcnt(0)" ::: "memory");
    float rli[16];
#pragma unroll
    for (int r = 0; r < 16; ++r) rli[r] = __builtin_amdgcn_rcpf(li_l[crow(r, hi)]);
    bf16_t* Ow = U.o + (size_t)(32 * (wid & 3)) * PK + head * 128;
#pragma unroll
    for (int r = 0; r < 16; ++r) { const int orow = crow(r, hi);
#pragma unroll
        for (int d0 = 0; d0 < 4; ++d0) Ow[(size_t)orow * PK + d0 * 32 + r32] = (bf16_t)f2bf(o[d0][r] * rli[r]); }
#undef TSRC
#undef SLOAD
#undef SWRITE
#undef SWAIT
#undef RESC
#undef MASK
}
}

__device__ __forceinline__ void phase_attention(const bf16_t* QKV, const bf16_t* CKB, const bf16_t* CVB, const float* sink, bf16_t* AO, LAS unsigned char* lds) {
    for (int un = blockIdx.x; un < 1024 + 256; un += gridDim.x) {
        attn::UnitDesc U;
        if (un < 1024) { const int hp = un & 1, qb = (un >> 1) & 15, g = (un >> 5) & 3, b = un >> 7; const int row0 = M_P + b * T_S, q0 = qb * 128;
            U.q = QKV + (size_t)(row0 + q0) * PQ; U.ctxK = CKB + ((size_t)b * 512 * 4 + g) * 128; U.ctxV = CVB + ((size_t)b * 512 * 4 + g) * 128;
            U.bandK = QKV + (size_t)row0 * PQ + 2048 + g * 128; U.bandV = QKV + (size_t)row0 * PQ + 2560 + g * 128; U.o = AO + (size_t)(row0 + q0) * PK;
            const int lo = max(q0 - 128, 0), hiq = min(q0 + 256, T_S);
            U.nctx = 8; U.band_lo = lo; U.nband = (hiq - lo) / 64; U.q0 = q0; U.masked = 1; U.head0 = 4 * g + 2 * hp; }
        else { const int j = un - 1024; const int hp = j & 1, qb = (j >> 1) & 1, g = (j >> 2) & 3, b = j >> 4; const int row0 = b * T_P, q0 = qb * 128;
            U.q = QKV + (size_t)(row0 + q0) * PQ; U.ctxK = nullptr; U.ctxV = nullptr;
            U.bandK = QKV + (size_t)row0 * PQ + 2048 + g * 128; U.bandV = QKV + (size_t)row0 * PQ + 2560 + g * 128; U.o = AO + (size_t)(row0 + q0) * PK;
            U.nctx = 0; U.band_lo = 0; U.nband = 4; U.q0 = q0; U.masked = 0; U.head0 = 4 * g + 2 * hp; }
        __syncthreads();
        attn::attn_unit(U, sink, (LAS char*)lds);
    }
}

constexpr int PH_PER_LAYER = 12, N_PHASES = 1 + 4 * PH_PER_LAYER;
__host__ __device__ constexpr int kind_of_layer(int l) { return l % 3; }
__host__ __device__ inline bool phase_active(int ph) {
    if (ph == 0) return true;
    const int l = (ph - 1) / PH_PER_LAYER, j = (ph - 1) % PH_PER_LAYER, kind = kind_of_layer(l);
    if (j >= 6) return j <= 9;
    return kind == 0 ? j <= 1 : j <= 4;
}

__global__ void __launch_bounds__(NTHREADS, 2) mega_fwd(Args A) {
    extern __shared__ __attribute__((aligned(16))) unsigned char lds_raw[];
    LAS unsigned char* lds = (LAS unsigned char*)lds_raw;
    const int tid = threadIdx.x;
    unsigned char* ws = A.ws;
    volatile LAS unsigned* misc = (volatile LAS unsigned*)(lds + LDS_MISC);
    if (tid < 4) misc[tid] = 0u;
    __syncthreads();
    const int lo = A.ph_lo, hi = A.ph_hi;
    const bool multi = (hi - lo) > 1;
    XcdBarrier bar; bar.bar = (unsigned*)(ws + WS_CTL) + CW_BAR; bar.x = 0; bar.st = misc;
    if (multi) bar = xcd_barrier_post((unsigned*)(ws + WS_CTL) + CW_BAR, misc);
#ifndef SEL_KIND
#define SITE(k, j) true
#else
#define SITE(k, j) ((SEL_KIND) == (k) && (SEL_J) == (j))
#endif
#define IN(k) (lo <= (k) && (k) < hi)
#define SEAM() do { if (multi) xcd_barrier(bar); } while (0)

    float* X = A.out + OUT_X;
    bf16_t* XB = (bf16_t*)(ws + WS_XB);
    float* rowsq = (float*)(ws + WS_RSQ);
    const float* mod = (const float*)(ws + WS_MOD);

    if (SITE(8, 0) && IN(0)) for (int rep_ = 0; rep_ < REP_PRO; ++rep_) { phase_prologue(A, lds); SEAM(); }

    for (int l = 0; l < 4; ++l) {
        const int base = 1 + PH_PER_LAYER * l, kind = kind_of_layer(l), slot = l / 3;
        const float* modl = mod + (size_t)l * NCOND * MODW;
        const RowSq rs_in{rowsq + (size_t)(2 * l) * RSQ_PARTS * M, l == 0 ? 1 : RSQ_PARTS}; float* rs_mid = rowsq + (size_t)(2 * l + 1) * RSQ_PARTS * M; float* rs_out = rowsq + (size_t)(2 * l + 2) * RSQ_PARTS * M;
        const float* nmix = A.in[I_NMIX] + l * DM; const float* nffn = A.in[I_NFFN] + l * DM;
        if (kind == 0) {
            if (SITE(0, 0) && IN(base + 0)) for (int rep_ = 0; rep_ < REP_ELEM; ++rep_) { phase_pool_elem(A.in[I_XP], A.in[I_XS], l == 0 ? nullptr : XB, rs_in, nmix, modl, modl + DM, (bf16_t*)(ws + WS_H), lds); SEAM(); }
            if (SITE(0, 1) && IN(base + 1)) {
                ProbPool P{(const bf16_t*)(ws + WS_H), (const bf16_t*)(ws + WS_WPOOL) + (size_t)slot * DM * PPW, PK, PPW, 512, M / 256, 8};
                EpiResid E{X, XB, modl + 2 * DM, A.in[I_POOLS] + slot * DM, rs_mid, A.in[I_XP], A.in[I_XS], l == 0 ? 0 : 1};
                pg8::gemm_phase<EpiResid, ProbPool, true, true>(lds, P, E);
                SEAM(); }
        } else if (kind == 1) {
            if (SITE(1, 0) && IN(base + 0)) for (int rep_ = 0; rep_ < REP_ELEM; ++rep_) { phase_rwkv_shift(XB, rs_in, nmix, modl, modl + DM, A.in[I_MU], (bf16_t*)(ws + WS_X6), lds); SEAM(); }
            if (SITE(1, 1) && IN(base + 1)) for (int rep_ = 0; rep_ < REP_RW; ++rep_) {
                ProbRwkv1 P{(const bf16_t*)(ws + WS_X6), (const bf16_t*)(ws + WS_WR), (const bf16_t*)(ws + WS_WL1), PK, PK, DM, M / 256, 27};
                EpiRwkv1 E{(bf16_t*)(ws + WS_RKV), (bf16_t*)(ws + WS_L1)};
                pg8::gemm_phase<EpiRwkv1, ProbRwkv1, true, true>(lds, P, E);
                SEAM(); }
            if (SITE(1, 2) && IN(base + 2)) for (int rep_ = 0; rep_ < REP_RW * REP_G2; ++rep_) {
                ProbRwkv2 P{(const bf16_t*)(ws + WS_L1), (const bf16_t*)(ws + WS_WW2), (const bf16_t*)(ws + WS_WA2), (const bf16_t*)(ws + WS_WG2), PL1, PW2, 256, M / 256, 40};
                EpiRwkv2 E{(float*)(ws + WS_DEC), (bf16_t*)(ws + WS_AA), (bf16_t*)(ws + WS_G), A.in[I_W0], A.in[I_A0]};
                pg8::gemm_phase<EpiRwkv2, ProbRwkv2, true, true>(lds, P, E);
                SEAM(); }
            if (SITE(1, 3) && IN(base + 3)) for (int rep_ = 0; rep_ < REP_SCAN; ++rep_) {
                ScanArgs S{(const bf16_t*)(ws + WS_RKV), (const bf16_t*)(ws + WS_RKV + SZ_H), (const bf16_t*)(ws + WS_RKV + 2 * SZ_H), (const float*)(ws + WS_DEC), (const bf16_t*)(ws + WS_AA),
                           (const bf16_t*)(ws + WS_G), (bf16_t*)(ws + WS_OFB), (bf16_t*)(ws + WS_Y), A.in[I_STATE], A.out + OUT_STATE, A.in[I_KK], A.in[I_KA], A.in[I_RK], A.in[I_LNW], A.in[I_LNB]};
                phase_scan(S, lds);
                SEAM(); }
        } else {
            if (SITE(2, 0) && IN(base + 0)) for (int rep_ = 0; rep_ < REP_ELEM; ++rep_) { phase_normmod(XB, rs_in, nmix, modl, modl + DM, (bf16_t*)(ws + WS_H)); SEAM(); }
            if (SITE(2, 1) && IN(base + 1)) {
                ProbSimple P{(const bf16_t*)(ws + WS_H), (const bf16_t*)(ws + WS_WQKV), PK, PK, DM, M / 256, 12};
                EpiBf16 E{(bf16_t*)(ws + WS_QKVB), PQ};
                pg8::gemm_phase<EpiBf16, ProbSimple, true, true>(lds, P, E);
                SEAM(); }
            if (SITE(2, 2) && IN(base + 2)) { phase_qk_norm_rope((bf16_t*)(ws + WS_QKVB), A.in[I_QN], A.in[I_KN], A.out + OUT_CK, A.out + OUT_CV, lds); SEAM(); }
            if (SITE(2, 3) && IN(base + 3)) for (int rep_ = 0; rep_ < REP_ATTN; ++rep_) { phase_attention((const bf16_t*)(ws + WS_QKVB), (const bf16_t*)(ws + WS_CKB), (const bf16_t*)(ws + WS_CVB), A.in[I_SINK], (bf16_t*)(ws + WS_AOB), lds); SEAM(); }
        }
        if (SITE(7, 4) && kind != 0 && IN(base + 4)) {
            ProbSimple P{(const bf16_t*)(ws + (kind == 1 ? WS_Y : WS_AOB)), (const bf16_t*)(ws + (kind == 1 ? WS_WR + 3 * SZ_SQ : WS_WAO)), PK, PK, DM, M / 256, 8};
            EpiResid E{X, XB, modl + 2 * DM, nullptr, rs_mid, nullptr, nullptr, 1};
            pg8::gemm_phase<EpiResid, ProbSimple, true, true>(lds, P, E);
            if (l == 1) { const int G = gridDim.x, rem = (M / 256 * 8) % G, bx = blockIdx.x;
                if (rem == 0) convert_weights(A, lds, 2, 2, bx * NWAVES + (opaque_tid() >> 6), G * NWAVES);
                else if (bx >= rem) convert_weights(A, lds, 2, 2, (bx - rem) * NWAVES + (opaque_tid() >> 6), (G - rem) * NWAVES); }
            SEAM(); }
        if (SITE(9, 6) && IN(base + 6)) for (int rep_ = 0; rep_ < REP_ELEM; ++rep_) { phase_normmod(XB, RowSq{rs_mid, RSQ_PARTS}, nffn, modl + 3 * DM, modl + 4 * DM, (bf16_t*)(ws + WS_H)); SEAM(); }
        if (SITE(9, 7) && IN(base + 7)) for (int rep_ = 0; rep_ < REP_UP; ++rep_) {
            ProbSimple P{(const bf16_t*)(ws + WS_H), (const bf16_t*)(ws + WS_WUP + (size_t)l * SZ_UP), PK, PK, DM, M / 256, FF2 / 256};
            EpiUpConv E{(bf16_t*)(ws + WS_ACTB), (float*)(ws + WS_U), A.in[I_CONVW] + (size_t)l * 3 * FF2, A.in[I_CONVB] + (size_t)l * FF2, (LAS float*)(lds + 131072)};
            pg8::gemm_phase<EpiUpConv, ProbSimple, true, true>(lds, P, E);
            SEAM(); }
        if (SITE(9, 8) && IN(base + 8)) for (int rep_ = 0; rep_ < REP_CONV; ++rep_) { phase_conv_fix((const float*)(ws + WS_U), A.in[I_CONVW] + (size_t)l * 3 * FF2, A.in[I_CONVB] + (size_t)l * FF2, (bf16_t*)(ws + WS_ACTB)); SEAM(); }
        if (SITE(9, 9) && IN(base + 9)) {
            ProbSimple P{(const bf16_t*)(ws + WS_ACTB), (const bf16_t*)(ws + WS_WDN + (size_t)l * SZ_DN), PF, PF, FF, M / 256, 8};
            EpiResid E{X, XB, modl + 5 * DM, nullptr, rs_out, nullptr, nullptr, l == 3 ? 2 : 1};
            pg8::gemm_phase<EpiResid, ProbSimple, true, true>(lds, P, E);
            if (l < 3) {
                const int G = gridDim.x, rem = (M / 256 * 8) % G, bx = blockIdx.x;
                const int part = l == 2 ? 0 : 1;
                if (rem == 0) convert_weights(A, lds, l + 1, part, bx * NWAVES + (opaque_tid() >> 6), G * NWAVES);
                else if (bx >= rem) convert_weights(A, lds, l + 1, part, (bx - rem) * NWAVES + (opaque_tid() >> 6), (G - rem) * NWAVES); }
            SEAM(); }
    }
#undef IN
#undef SEAM
}

extern "C" void kernel_launch(void* const* d_in, const int* in_sizes, int n_in, void* d_out, int out_size, void* d_ws, size_t ws_size, hipStream_t stream) {
    static int grid = 0;
    if (grid == 0) {
        if (n_in != N_IN || (size_t)out_size != OUT_TOTAL || ws_size < WS_END) {
            fprintf(stderr, "kernel_launch: built for %d inputs, %zu outputs, >= %zu bytes of workspace; got n_in %d, out %d, ws %zu; nothing launched\n", (int)N_IN, (size_t)OUT_TOTAL, (size_t)WS_END, n_in, out_size, ws_size);
            grid = -1; return; }
        int dev = 0, cus = 0, per_cu = 0;
        if (hipGetDevice(&dev) != hipSuccess || hipDeviceGetAttribute(&cus, hipDeviceAttributeMultiprocessorCount, dev) != hipSuccess) { fprintf(stderr, "kernel_launch: device query failed\n"); grid = -1; return; }
        if (hipFuncSetAttribute((const void*)mega_fwd, hipFuncAttributeMaxDynamicSharedMemorySize, LDS_BYTES) != hipSuccess) { fprintf(stderr, "kernel_launch: hipFuncSetAttribute failed\n"); grid = -1; return; }
        if (hipOccupancyMaxActiveBlocksPerMultiprocessor(&per_cu, (const void*)mega_fwd, NTHREADS, LDS_BYTES) != hipSuccess || per_cu < 1)
            fprintf(stderr, "kernel_launch: note: occupancy query reports %d workgroups per CU\n", per_cu);
        (void)hipGetLastError();
        grid = cus;
    }
    if (grid < 0) return;
    unsigned char* ws = (unsigned char*)d_ws;
    (void)hipMemsetAsync(ws + WS_CTL, 0, CTL_BYTES, stream);
    Args a{};
    for (int i = 0; i < N_IN; ++i) a.in[i] = (const float*)d_in[i];
    a.out = (float*)d_out; a.ws = ws;
#if MK_ONE_LAUNCH
    a.ph_lo = 0; a.ph_hi = N_PHASES;
    hipLaunchKernelGGL(mega_fwd, dim3(grid), dim3(NTHREADS), LDS_BYTES, stream, a);
#else
    for (int ph = 0; ph < MK_MAX_PHASE; ++ph) {
        if (!phase_active(ph)) continue;
        a.ph_lo = ph; a.ph_hi = ph + 1;
        hipLaunchKernelGGL(mega_fwd, dim3(grid), dim3(NTHREADS), LDS_BYTES, stream, a);
    }
#endif
    const hipError_t le = hipPeekAtLastError();
    if (le != hipSuccess) fprintf(stderr, "kernel_launch: launch failed: %s\n", hipGetErrorName(le));
}
```
